# Optimizing an MI355X kernel written in HIP

```python
import math
import jax, jax.numpy as jnp
from jax import lax
import numpy as np

D_MODEL = 1024
BATCH = 16
SEQ = 2048
DEPTH = 2

GRID_W = 64
CTX_LEN = 256
N_EVEN = (DEPTH + 1) // 2
N_ODD = DEPTH // 2
MIX_WIDTH = D_MODEL
DA_HEADS = 4
DA_DK = 64
DA_DV = 2 * DA_DK
MLA_HEADS = 4
MLA_NOPE = 128
MLA_ROPE = 64
MLA_V = 128
MLA_Q_LORA = 256
MLA_KV_LORA = 128
EV_IN = 3 * DA_HEADS * 2 * DA_DK + MLA_Q_LORA + MLA_KV_LORA + MLA_ROPE
NA_HEADS = 16
NA_DH = 64
NA_KH = 8
NA_KW = 16
D_FF = -(-8 * D_MODEL // (3 * 256)) * 256
ROPE_THETA = 10000.0
Q_BLOCK = 128
EPS = 1e-6
NEG_INF = -1e30

kernel_name = "hybrid_diffattn_mla_natten_prefix_block"


def rms_norm(x, g):
    xf = x.astype(jnp.float32)
    y = xf * lax.rsqrt(jnp.mean(xf * xf, axis=-1, keepdims=True) + EPS)
    return (y * g.astype(jnp.float32)).astype(x.dtype)


def softmax_f32(s):
    return jax.nn.softmax(s.astype(jnp.float32), axis=-1)


def adaln(cond, mod_w, mod_b):
    return jnp.split(jax.nn.silu(cond) @ mod_w + mod_b, 6, axis=-1)


def modulate(h, shift, scale):
    return h * (1 + scale) + shift


def swiglu(h, w_in, w_out):
    g, u = jnp.split(h @ w_in, 2, axis=-1)
    return (jax.nn.silu(g) * u) @ w_out


def axial_rope_tables(S, dim):
    t = jnp.arange(S)
    row = (t // GRID_W).astype(jnp.float32)
    col = (t % GRID_W).astype(jnp.float32)
    half = dim // 2
    inv = ROPE_THETA ** (-jnp.arange(0, half, 2, dtype=jnp.float32) / half)
    ar = row[:, None] * inv
    ac = col[:, None] * inv
    return (jnp.cos(ar), jnp.sin(ar), jnp.cos(ac), jnp.sin(ac))


def _rotate(x, cos, sin):
    x1, x2 = jnp.split(x, 2, axis=-1)
    return jnp.concatenate([x1 * cos - x2 * sin, x1 * sin + x2 * cos], axis=-1)


def apply_axial_rope(x, tables):
    cr, sr, cc, sc = tables
    xr, xc = jnp.split(x, 2, axis=-1)
    return jnp.concatenate([_rotate(xr, cr, sr), _rotate(xc, cc, sc)], axis=-1).astype(x.dtype)


def sweep_query_blocks(fn, *qs):
    S = qs[0].shape[-2]
    nb = S // Q_BLOCK
    blocks = tuple(jnp.moveaxis(q.reshape(q.shape[:-2] + (nb, Q_BLOCK, q.shape[-1])), -3, 0) for q in qs)
    out = lax.map(lambda a: fn(*a), blocks)
    out = jnp.moveaxis(out, 0, -3)
    return out.reshape(out.shape[:-3] + (S, out.shape[-1]))


def merge_heads(*outs):
    return jnp.concatenate([o.transpose(0, 2, 1, 3).reshape(o.shape[0], o.shape[2], -1) for o in outs], axis=-1)


def even_project(h, w_in, da_q_g, da_k_g, mla_q_a_g, mla_w_uq, mla_kv_a_g, mla_w_ukv, mla_q_g, mla_k_g, mla_kr_g):
    B, T, _ = h.shape
    n_dq = DA_HEADS * 2 * DA_DK
    idx = [n_dq, 2 * n_dq, 3 * n_dq, 3 * n_dq + MLA_Q_LORA, 3 * n_dq + MLA_Q_LORA + MLA_KV_LORA]
    dq, dk, dv, cq, ckv, kr = jnp.split(h @ w_in, idx, axis=-1)
    dq = rms_norm(dq.reshape(B, T, DA_HEADS, 2, DA_DK), da_q_g).transpose(0, 2, 3, 1, 4)
    dk = rms_norm(dk.reshape(B, T, DA_HEADS, 2, DA_DK), da_k_g).transpose(0, 2, 3, 1, 4)
    dv = dv.reshape(B, T, DA_HEADS, DA_DV).transpose(0, 2, 1, 3)
    q = (rms_norm(cq, mla_q_a_g) @ mla_w_uq).reshape(B, T, MLA_HEADS, MLA_NOPE + MLA_ROPE)
    q = rms_norm(q, mla_q_g).transpose(0, 2, 1, 3)
    qn, qr = q[..., :MLA_NOPE], q[..., MLA_NOPE:]
    kv = (rms_norm(ckv, mla_kv_a_g) @ mla_w_ukv).reshape(B, T, MLA_HEADS, MLA_NOPE + MLA_V)
    kn = rms_norm(kv[..., :MLA_NOPE], mla_k_g).transpose(0, 2, 1, 3)
    mv = kv[..., MLA_NOPE:].transpose(0, 2, 1, 3)
    kr = rms_norm(kr, mla_kr_g)
    return dq, dk, dv, qn, qr, kn, kr, mv


def diff_attend(q, k, v, lam, lam_init, out_g):
    s = jnp.einsum('bhiqd,bhikd->bhiqk', q, k) * (DA_DK ** -0.5)
    p = softmax_f32(s)
    a = p[:, :, 0] - lam * p[:, :, 1]
    o = jnp.einsum('bhqk,bhkd->bhqd', a.astype(v.dtype), v)
    return rms_norm(o, out_g) * (1.0 - lam_init)


def mla_attend(qn, qr, kn, kr, v):
    s = (jnp.einsum('bhqd,bhkd->bhqk', qn, kn) + jnp.einsum('bhqd,bkd->bhqk', qr, kr)) * ((MLA_NOPE + MLA_ROPE) ** -0.5)
    p = softmax_f32(s)
    return jnp.einsum('bhqk,bhkd->bhqd', p.astype(v.dtype), v)


def even_mixer(hx, hc, need_ctx, w_in, da_q_g, da_k_g, lam, lam_init, da_out_g,
               mla_q_a_g, mla_w_uq, mla_kv_a_g, mla_w_ukv, mla_q_g, mla_k_g, mla_kr_g):
    proj = lambda h: even_project(h, w_in, da_q_g, da_k_g, mla_q_a_g, mla_w_uq, mla_kv_a_g, mla_w_ukv,
                                  mla_q_g, mla_k_g, mla_kr_g)
    dq_x, dk_x, dv_x, qn_x, qr_x, kn_x, kr_x, mv_x = proj(hx)
    dq_c, dk_c, dv_c, qn_c, qr_c, kn_c, kr_c, mv_c = proj(hc)
    S = hx.shape[1]
    tab_da = axial_rope_tables(S, DA_DK)
    tab_mla = axial_rope_tables(S, MLA_ROPE)
    dq_x = apply_axial_rope(dq_x, tab_da)
    dk_x = apply_axial_rope(dk_x, tab_da)
    qr_x = apply_axial_rope(qr_x, tab_mla)
    kr_x = apply_axial_rope(kr_x, tab_mla)
    dk_all = jnp.concatenate([dk_c, dk_x], axis=-2)
    dv_all = jnp.concatenate([dv_c, dv_x], axis=-2)
    kn_all = jnp.concatenate([kn_c, kn_x], axis=-2)
    kr_all = jnp.concatenate([kr_c, kr_x], axis=-2)
    mv_all = jnp.concatenate([mv_c, mv_x], axis=-2)
    da_x = sweep_query_blocks(lambda q: diff_attend(q, dk_all, dv_all, lam, lam_init, da_out_g), dq_x)
    mla_x = sweep_query_blocks(lambda a, b: mla_attend(a, b, kn_all, kr_all, mv_all), qn_x, qr_x)
    y_x = merge_heads(da_x, mla_x)
    y_c = None
    if need_ctx:
        da_c = diff_attend(dq_c, dk_c, dv_c, lam, lam_init, da_out_g)
        mla_c = mla_attend(qn_c, qr_c, kn_c, kr_c, mv_c)
        y_c = merge_heads(da_c, mla_c)
    return y_x, y_c


def odd_project(h, w_in, q_g, k_g):
    B, T, _ = h.shape
    q, k, v = jnp.split((h @ w_in).reshape(B, T, 3 * NA_HEADS, NA_DH), 3, axis=2)
    q = rms_norm(q, q_g).transpose(0, 2, 1, 3)
    k = rms_norm(k, k_g).transpose(0, 2, 1, 3)
    return q, k, v.transpose(0, 2, 1, 3)


def dense_attend(q, k, v):
    p = softmax_f32(jnp.einsum('bhqd,bhkd->bhqk', q, k) * (NA_DH ** -0.5))
    return jnp.einsum('bhqk,bhkd->bhqd', p.astype(v.dtype), v)


def na_latent(q, k, v, kc, vc, rpb):
    B, H, S, d = q.shape
    rows = S // GRID_W
    kh = min(NA_KH, rows)
    kg = k.reshape(B, H, rows, GRID_W, d)
    vg = v.reshape(B, H, rows, GRID_W, d)
    qg = q.reshape(B, H, rows, GRID_W, d)
    cols = jnp.arange(GRID_W)
    col_start = jnp.clip(cols - NA_KW // 2, 0, GRID_W - NA_KW)
    col_valid = (cols[None, :] >= col_start[:, None]) & (cols[None, :] < col_start[:, None] + NA_KW)
    dc_idx = jnp.clip(cols[None, :] - cols[:, None], -(NA_KW - 1), NA_KW - 1) + NA_KW - 1
    rpb_c = rpb[:, :, dc_idx]
    scale = NA_DH ** -0.5

    def row_step(args):
        r, q_row = args
        rs = jnp.clip(r - kh // 2, 0, rows - kh)
        kb = lax.dynamic_slice_in_dim(kg, rs, kh, axis=2)
        vb = lax.dynamic_slice_in_dim(vg, rs, kh, axis=2)
        dr_idx = rs + jnp.arange(kh) - r + NA_KH - 1
        bias = jnp.take(rpb_c, dr_idx, axis=1).transpose(0, 2, 1, 3)
        s_loc = jnp.einsum('bhqd,bhiwd->bhqiw', q_row, kb).astype(jnp.float32) * scale + bias
        s_loc = jnp.where(col_valid[:, None, :], s_loc, NEG_INF).reshape(B, H, GRID_W, kh * GRID_W)
        s_ctx = jnp.einsum('bhqd,bhkd->bhqk', q_row, kc).astype(jnp.float32) * scale
        p = softmax_f32(jnp.concatenate([s_loc, s_ctx], axis=-1))
        p_loc = p[..., :kh * GRID_W].reshape(B, H, GRID_W, kh, GRID_W).astype(v.dtype)
        p_ctx = p[..., kh * GRID_W:].astype(v.dtype)
        return jnp.einsum('bhqiw,bhiwd->bhqd', p_loc, vb) + jnp.einsum('bhqk,bhkd->bhqd', p_ctx, vc)

    out = lax.map(row_step, (jnp.arange(rows), jnp.moveaxis(qg, 2, 0)))
    return jnp.moveaxis(out, 0, 2).reshape(B, H, S, d)


def odd_mixer(hx, hc, need_ctx, w_in, q_g, k_g, rpb):
    q_x, k_x, v_x = odd_project(hx, w_in, q_g, k_g)
    q_c, k_c, v_c = odd_project(hc, w_in, q_g, k_g)
    y_x = merge_heads(na_latent(q_x, k_x, v_x, k_c, v_c, rpb))
    y_c = merge_heads(dense_attend(q_c, k_c, v_c)) if need_ctx else None
    return y_x, y_c


def setup_inputs(seed: int = 0) -> dict:
    key = jax.random.key(seed)
    ks = iter(jax.random.split(key, 40))
    nrm = lambda shape, s: jax.random.normal(next(ks), shape, jnp.float32) * s
    gain = lambda shape: 1.0 + 0.1 * jax.random.normal(next(ks), shape, jnp.float32)
    D = D_MODEL
    return {
        "x": nrm((BATCH, SEQ, D), 1.0),
        "c": nrm((BATCH, D), 1.0),
        "ctx": nrm((BATCH, CTX_LEN, D), 1.0),
        "c_ctx": nrm((D,), 1.0),
        "mod_w": nrm((DEPTH, D, 6 * D), 0.5 * D ** -0.5),
        "mod_b": nrm((DEPTH, 6 * D), 0.02),
        "norm_mix_g": gain((DEPTH, D)),
        "norm_ffn_g": gain((DEPTH, D)),
        "w_out": nrm((DEPTH, MIX_WIDTH, D), MIX_WIDTH ** -0.5),
        "ffn_w_in": nrm((DEPTH, D, 2 * D_FF), D ** -0.5),
        "ffn_w_out": nrm((DEPTH, D_FF, D), D_FF ** -0.5),
        "ev_w_in": nrm((N_EVEN, D, EV_IN), D ** -0.5),
        "da_q_g": gain((N_EVEN, DA_DK)),
        "da_k_g": gain((N_EVEN, DA_DK)),
        "da_lq1": nrm((N_EVEN, DA_DK), 0.1),
        "da_lk1": nrm((N_EVEN, DA_DK), 0.1),
        "da_lq2": nrm((N_EVEN, DA_DK), 0.1),
        "da_lk2": nrm((N_EVEN, DA_DK), 0.1),
        "da_out_g": gain((N_EVEN, DA_DV)),
        "mla_q_a_g": gain((N_EVEN, MLA_Q_LORA)),
        "mla_w_uq": nrm((N_EVEN, MLA_Q_LORA, MLA_HEADS * (MLA_NOPE + MLA_ROPE)), MLA_Q_LORA ** -0.5),
        "mla_kv_a_g": gain((N_EVEN, MLA_KV_LORA)),
        "mla_w_ukv": nrm((N_EVEN, MLA_KV_LORA, MLA_HEADS * (MLA_NOPE + MLA_V)), MLA_KV_LORA ** -0.5),
        "mla_q_g": gain((N_EVEN, MLA_NOPE + MLA_ROPE)),
        "mla_k_g": gain((N_EVEN, MLA_NOPE)),
        "mla_kr_g": gain((N_EVEN, MLA_ROPE)),
        "od_w_in": nrm((N_ODD, D, 3 * NA_HEADS * NA_DH), D ** -0.5),
        "na_q_g": gain((N_ODD, NA_DH)),
        "na_k_g": gain((N_ODD, NA_DH)),
        "na_rpb": nrm((N_ODD, NA_HEADS, 2 * NA_KH - 1, 2 * NA_KW - 1), 0.5),
    }


def reference(x, c, ctx, c_ctx, mod_w, mod_b, norm_mix_g, norm_ffn_g, w_out, ffn_w_in, ffn_w_out,
              ev_w_in, da_q_g, da_k_g, da_lq1, da_lk1, da_lq2, da_lk2, da_out_g,
              mla_q_a_g, mla_w_uq, mla_kv_a_g, mla_w_ukv, mla_q_g, mla_k_g, mla_kr_g,
              od_w_in, na_q_g, na_k_g, na_rpb):
    for l in range(DEPTH):
        need_ctx = l < DEPTH - 1
        sh_a, sc_a, g_a, sh_f, sc_f, g_f = [m[:, None, :] for m in adaln(c, mod_w[l], mod_b[l])]
        csh_a, csc_a, cg_a, csh_f, csc_f, cg_f = adaln(c_ctx, mod_w[l], mod_b[l])
        hx = modulate(rms_norm(x, norm_mix_g[l]), sh_a, sc_a)
        hc = modulate(rms_norm(ctx, norm_mix_g[l]), csh_a, csc_a)
        e = l // 2
        if l % 2 == 0:
            lam_init = 0.8 - 0.6 * math.exp(-0.3 * l)
            lam = (jnp.exp(jnp.sum(da_lq1[e] * da_lk1[e]).astype(jnp.float32))
                   - jnp.exp(jnp.sum(da_lq2[e] * da_lk2[e]).astype(jnp.float32)) + lam_init)
            y_x, y_c = even_mixer(hx, hc, need_ctx, ev_w_in[e], da_q_g[e], da_k_g[e], lam, lam_init, da_out_g[e],
                                  mla_q_a_g[e], mla_w_uq[e], mla_kv_a_g[e], mla_w_ukv[e],
                                  mla_q_g[e], mla_k_g[e], mla_kr_g[e])
        else:
            y_x, y_c = odd_mixer(hx, hc, need_ctx, od_w_in[e], na_q_g[e], na_k_g[e], na_rpb[e])
        x = x + g_a * (y_x @ w_out[l])
        x = x + g_f * swiglu(modulate(rms_norm(x, norm_ffn_g[l]), sh_f, sc_f), ffn_w_in[l], ffn_w_out[l])
        if need_ctx:
            ctx = ctx + cg_a * (y_c @ w_out[l])
            ctx = ctx + cg_f * swiglu(modulate(rms_norm(ctx, norm_ffn_g[l]), csh_f, csc_f), ffn_w_in[l], ffn_w_out[l])
    return x
```

```cpp
#include <hip/hip_runtime.h>
#include <hip/hip_cooperative_groups.h>
#include <cstdio>
#include <cstdint>
namespace cg = cooperative_groups;

namespace pg8 {
#define PG8_LAS __attribute__((address_space(3)))
typedef unsigned short bf16_t;
typedef short bf16x8 __attribute__((ext_vector_type(8)));
typedef float f32x4 __attribute__((ext_vector_type(4)));
typedef unsigned u32x4 __attribute__((ext_vector_type(4)));
constexpr int BM = 256, BK = 64, HALF = 128, HTB = HALF * BK * 2  , STAGE_BYTES = 8 * HTB, NXCD = 8, WGM = 8;

__host__ __device__ __forceinline__ int lds_byte(int r, int c) { const int st = (r >> 4) * 2 + (c >> 5), rr = r & 15, cc = c & 31, ob = rr * 64 + cc * 2; return st * 1024 + (ob ^ (((ob >> 9) & 1) << 5)); }
__host__ __device__ __forceinline__ void stage_rc(int b, int& R, int& C) { const int st = b / 1024, sb = b % 1024, swz = sb ^ (((sb >> 9) & 1) << 5); R = (st >> 1) * 16 + swz / 64; C = (st & 1) * 32 + (swz % 64) / 2; }
__host__ __device__ __forceinline__ int perm32(int rho) { const int n = rho >> 4, i = rho & 15; return 8 * (i >> 2) + 4 * n + (i & 3); }

struct Unit { int pm, pn, aoff; };
struct Gemm { const bf16_t* A; const bf16_t* Bt; int M, N, K, lda; };

struct StaticOrder {
    int nM, nN, nwg, G, c;
    __host__ __device__ void init(int M, int N, int G_, int c_) { nM = M / BM; nN = N / BM; nwg = nM * nN; G = G_; c = c_; }
    __host__ __device__ bool next(int i, Unit& u) const {
        const long L = (long)i * G + c; if (L >= nwg) return false;
        int wgid = (int)L; { const int q = nwg / NXCD, r = nwg % NXCD, xcd = wgid % NXCD, off = wgid / NXCD; wgid = (xcd < r ? xcd * (q + 1) : r * (q + 1) + (xcd - r) * q) + off; }
        const int nig = WGM * nN, gid = wgid / nig, fm = gid * WGM, gsz = (nM - fm) < WGM ? (nM - fm) : WGM;
        u.pm = fm + ((wgid % nig) % gsz); u.pn = (wgid % nig) / gsz; u.aoff = 0; return true;
    }
    __device__ __forceinline__ void a_ready(const Unit&) const {}
    __device__ __forceinline__ void done(const Unit&) const {}
};

typedef float f32x2_t __attribute__((ext_vector_type(2))); typedef __bf16 bf16x2_t __attribute__((ext_vector_type(2))); typedef unsigned u32x2 __attribute__((ext_vector_type(2)));
__device__ __forceinline__ unsigned cvtpk(float lo, float hi) { f32x2_t v = {lo, hi}; bf16x2_t b = __builtin_convertvector(v, bf16x2_t); return __builtin_bit_cast(unsigned, b); }


template <int N> __device__ __forceinline__ float dpp_ror_add(float v) { return v + __builtin_bit_cast(float, __builtin_amdgcn_update_dpp(0, __builtin_bit_cast(int, v), 0x120 + N, 0xf, 0xf, false)); }
__device__ __forceinline__ float sum_xor16(float v) { return v + __shfl_xor(v, 16); }
__device__ __forceinline__ void swap32(float& a, float& b) { asm volatile("v_nop\n\tv_nop\n\tv_permlane32_swap_b32 %0, %1" : "+v"(a), "+v"(b)); }
__device__ __forceinline__ float sum_xor32(float v) { float a = v, b = v; swap32(a, b); return a + b; }
__device__ __forceinline__ float partner_xor32(float v, bool upper) { float a = v, b = v; swap32(a, b); return upper ? a : b; }
__device__ __forceinline__ float wave_sum_fast(float v) { v += __shfl_xor(v, 1); v += __shfl_xor(v, 2); v += __shfl_xor(v, 4); v += __shfl_xor(v, 8); v += __shfl_xor(v, 16); return sum_xor32(v); }
struct LatentOrder : StaticOrder {
    __host__ __device__ void init(int N, int G_, int c_) { StaticOrder::init(128 * BM, N, G_, c_); }
    __host__ __device__ bool next(int i, Unit& u) const { if (!StaticOrder::next(i, u)) return false; u.pm = u.pm + u.pm / 8 + 1; return true; }
};


struct XcdOrder {
    int tile0, p, kind, gsz, nN, pn0, n, nB, nC, PA, PB;
    __host__ __device__ void init(int c, int kind_, int nN_, int pn0_, int pos, int nA_, int PA_, int nB_, int PB_, int nC_) {
        const int tp = kind_ == 0 ? 16 : 2; tile0 = tp * (c & 7); gsz = tp < 8 ? tp : 8; p = pos; kind = kind_; nN = nN_; pn0 = pn0_; nB = nB_; nC = nC_; PA = PA_; PB = PB_;
        int n_ = nC_; if (pos < PB_) n_ = nB_; if (pos < PA_) n_ = nA_; n = n_; }
    __host__ __device__ bool next(int i, Unit& u) const {
        if (i >= n) return false;
        const int i1 = i < nC ? i : nC, i2 = i - nC < 0 ? 0 : (i - nC > nB - nC ? nB - nC : i - nC), i3 = i - nB < 0 ? 0 : i - nB;
        const int w = 32 * i1 + PB * i2 + PA * i3 + p;
        const int nig = gsz * nN, grp = w / nig, r = w % nig, t = tile0 + grp * gsz + r % gsz;
        u.pn = pn0 + r / gsz; u.pm = kind == 0 ? t + t / 8 + 1 : 9 * t; u.aoff = 0; return true;
    }
    __device__ __forceinline__ void a_ready(const Unit&) const {}
    __device__ __forceinline__ void done(const Unit&) const {}
};
struct EpiStore {
    static constexpr bool PERM = true, AFTER_DRAIN = false;
    bf16_t* O; int ldc;
    __device__ __forceinline__ void operator()(const f32x4 (&acc)[2][2][4][2], const Unit& u, int wr, int wc, int fr, int fq) const {
        const int row0 = u.pm * BM + wr * 64 + fr, col0 = u.pn * BM + wc * 32 + 8 * fq;
#pragma unroll
        for (int ai = 0; ai < 2; ++ai)
#pragma unroll
            for (int m = 0; m < 4; ++m) { bf16_t* rowp = O + (size_t)(row0 + ai * HALF + m * 16) * ldc + col0;
#pragma unroll
                for (int bj = 0; bj < 2; ++bj) { const f32x4 v0 = acc[ai][bj][m][0], v1 = acc[ai][bj][m][1];
                    u32x4 w; w.x = cvtpk(v0[0], v0[1]); w.y = cvtpk(v0[2], v0[3]); w.z = cvtpk(v1[0], v1[1]); w.w = cvtpk(v1[2], v1[3]);
                    *(u32x4*)(rowp + bj * HALF) = w; } }
    }
};
struct EpiRes {
    static constexpr bool PERM = false, AFTER_DRAIN = false;
    const float* base_lat; const float* base_ctx; float* out_lat; float* out_ctx; const float* modv_l; int chunk;
    __device__ __forceinline__ void operator()(const f32x4 (&acc)[2][2][4][2], const Unit& u, int wr, int wc, int fr, int fq) const {
        asm volatile("" : "+v"(fr), "+v"(fq) :: "memory");
        const int b = u.pm / 9, j = u.pm % 9;
        const float* __restrict__ bp; float* __restrict__ op; const float* gv;
        if (j == 0) { const size_t off = (size_t)b * 256 * 1024; bp = base_ctx + off; op = out_ctx + off; gv = modv_l + 16 * 6144 + chunk * 1024; }
        else { const size_t off = ((size_t)b * 2048 + (size_t)(j - 1) * 256) * 1024; bp = base_lat + off; op = out_lat + off; gv = modv_l + b * 6144 + chunk * 1024; }
        const int rl0 = wr * 64 + fr, col0 = u.pn * BM + wc * 32 + 4 * fq;
        f32x4 g[2][2];
#pragma unroll
        for (int bj = 0; bj < 2; ++bj)
#pragma unroll
            for (int n = 0; n < 2; ++n) g[bj][n] = *(const f32x4*)(gv + col0 + bj * HALF + n * 16);
#pragma unroll
        for (int ai = 0; ai < 2; ++ai)
#pragma unroll
            for (int m = 0; m < 4; ++m) { const size_t ro = (size_t)(rl0 + ai * HALF + m * 16) * 1024 + col0;
#pragma unroll
                for (int bj = 0; bj < 2; ++bj)
#pragma unroll
                    for (int n = 0; n < 2; ++n) { const f32x4 bs = *(const f32x4*)(bp + ro + bj * HALF + n * 16);
                        *(f32x4*)(op + ro + bj * HALF + n * 16) = bs + g[bj][n] * acc[ai][bj][m][n]; } }
    }
};
__device__ __forceinline__ float silu_mul(float g, float u) { return g * u * __builtin_amdgcn_rcpf(1.0f + __builtin_amdgcn_exp2f(-1.4426950408889634f * g)); }
struct EpiSwiGLU {
    static constexpr bool PERM = true, AFTER_DRAIN = false;
    bf16_t* H;
    __device__ __forceinline__ void operator()(const f32x4 (&acc)[2][2][4][2], const Unit& u, int wr, int wc, int fr, int fq) const {
        const int row0 = u.pm * BM + wr * 64 + fr, col0 = u.pn * HALF + wc * 32 + 8 * fq;
#pragma unroll
        for (int ai = 0; ai < 2; ++ai)
#pragma unroll
            for (int m = 0; m < 4; ++m) { bf16_t* rowp = H + (size_t)(row0 + ai * HALF + m * 16) * 2816 + col0;
                const f32x4 g0 = acc[ai][0][m][0], g1 = acc[ai][0][m][1], u0 = acc[ai][1][m][0], u1 = acc[ai][1][m][1];
                u32x4 w; w.x = cvtpk(silu_mul(g0[0], u0[0]), silu_mul(g0[1], u0[1])); w.y = cvtpk(silu_mul(g0[2], u0[2]), silu_mul(g0[3], u0[3]));
                w.z = cvtpk(silu_mul(g1[0], u1[0]), silu_mul(g1[1], u1[1])); w.w = cvtpk(silu_mul(g1[2], u1[2]), silu_mul(g1[3], u1[3]));
                *(u32x4*)rowp = w; }
    }
};

struct UpOrder : StaticOrder {
    __host__ __device__ bool next(int i, Unit& u) const { if (!StaticOrder::next(i, u)) return false; u.aoff = (u.pn < 3 ? 1536 : 1792) * 2; return true; }
};
struct EpiUp {
    static constexpr bool PERM = true, AFTER_DRAIN = false;
    bf16_t* Q; bf16_t* KV;
    const float* ssq_cq; const float* ssq_ckv;
    __device__ __forceinline__ void operator()(const f32x4 (&acc)[2][2][4][2], const Unit& u, int wr, int wc, int fr, int fq) const {
        asm volatile("" : "+v"(fr), "+v"(fq) :: "memory");
        const bool isq = u.pn < 3; bf16_t* O = isq ? Q : KV; const int ldc = isq ? 768 : 1024;
        const int row0 = u.pm * BM + wr * 64 + fr, col0 = (isq ? u.pn : u.pn - 3) * BM + wc * 32 + 8 * fq;
        const float* sq = isq ? ssq_cq : ssq_ckv; const float inv = isq ? (1.0f / 256.0f) : (1.0f / 128.0f);
        float rs[2][4];
#pragma unroll
        for (int ai = 0; ai < 2; ++ai)
#pragma unroll
            for (int m = 0; m < 4; ++m) rs[ai][m] = 1.0f / sqrtf(sq[row0 + ai * HALF + m * 16] * inv + 1e-6f);
#pragma unroll
        for (int ai = 0; ai < 2; ++ai)
#pragma unroll
            for (int m = 0; m < 4; ++m) { bf16_t* rowp = O + (size_t)(row0 + ai * HALF + m * 16) * ldc + col0;
#pragma unroll
                for (int bj = 0; bj < 2; ++bj) { const f32x4 v0 = acc[ai][bj][m][0] * rs[ai][m], v1 = acc[ai][bj][m][1] * rs[ai][m];
                    u32x4 w; w.x = cvtpk(v0[0], v0[1]); w.y = cvtpk(v0[2], v0[3]); w.z = cvtpk(v1[0], v1[1]); w.w = cvtpk(v1[2], v1[3]);
                    *(u32x4*)(rowp + bj * HALF) = w; } }
    }
};
struct ProjGroup { int kind; const float* gain; float oscale; int rope; float* ssq; };
template <bool NORMIN, class GroupFn> struct EpiProj {
    static constexpr bool PERM = true, AFTER_DRAIN = false;
    bf16_t* O; int ldc;
    const float* ssq_in; const float* shw; int shw_ld;
    const float* ropet;
    GroupFn gf;
    __device__ __forceinline__ void operator()(const f32x4 (&acc)[2][2][4][2], const Unit& u, int wr, int wc, int fr, int fq) const {
        asm volatile("" : "+v"(fr), "+v"(fq) :: "memory");
        const int g = 4 * u.pn + wc; const ProjGroup G = gf(g);
        const int b = u.pm / 9, j = u.pm % 9; const bool lat = j != 0; const int midx = lat ? b : 16;
        const int row0 = u.pm * BM + wr * 64 + fr;
        f32x4 shv[2][2], gn[2][2]; float rin[2][4];
#pragma unroll
        for (int bj = 0; bj < 2; ++bj)
#pragma unroll
            for (int n = 0; n < 2; ++n) { shv[bj][n] = NORMIN ? *(const f32x4*)(shw + (size_t)midx * shw_ld + u.pn * BM + bj * HALF + wc * 32 + 8 * fq + 4 * n) : (f32x4){0.f, 0.f, 0.f, 0.f};
                gn[bj][n] = (G.kind == 1) ? *(const f32x4*)(G.gain + 32 * bj + 8 * fq + 4 * n) : (f32x4){1.f, 1.f, 1.f, 1.f}; }
#pragma unroll
        for (int ai = 0; ai < 2; ++ai)
#pragma unroll
            for (int m = 0; m < 4; ++m) rin[ai][m] = NORMIN ? 1.0f / sqrtf(ssq_in[row0 + ai * HALF + m * 16] * (1.0f / 1024.0f) + 1e-6f) : 1.0f;
        if (!NORMIN) { const float dl = ropet[fq]; asm volatile("" :: "v"(dl)); }
        const bool do_rope = (G.kind == 1) && G.rope && lat;
        float invr[2][4];
#pragma unroll
        for (int n = 0; n < 2; ++n)
#pragma unroll
            for (int i = 0; i < 4; ++i) invr[n][i] = __builtin_amdgcn_exp2f(-(float)(8 * (fq & 1) + 4 * n + i) * 0.8304820237218405f) * 0.15915494309189535f;
#pragma unroll
        for (int ai = 0; ai < 2; ++ai)
#pragma unroll
            for (int m = 0; m < 4; ++m) {
                const int row = row0 + ai * HALF + m * 16;
                f32x4 v[2][2];
#pragma unroll
                for (int bj = 0; bj < 2; ++bj)
#pragma unroll
                    for (int n = 0; n < 2; ++n) v[bj][n] = NORMIN ? acc[ai][bj][m][n] * rin[ai][m] + shv[bj][n] : acc[ai][bj][m][n];
                if (G.kind != 0) {
                    float ss = 0.f;
#pragma unroll
                    for (int bj = 0; bj < 2; ++bj)
#pragma unroll
                        for (int n = 0; n < 2; ++n) ss += (v[bj][n][0] * v[bj][n][0] + v[bj][n][1] * v[bj][n][1]) + (v[bj][n][2] * v[bj][n][2] + v[bj][n][3] * v[bj][n][3]);
                    ss = sum_xor32(sum_xor16(ss));
                    if (G.kind == 2) { if (fq == 0) atomicAdd(G.ssq + row, ss); }
                    else {
                        const float rstd = 1.0f / sqrtf(ss * (1.0f / 64.0f) + 1e-6f);
#pragma unroll
                        for (int bj = 0; bj < 2; ++bj)
#pragma unroll
                            for (int n = 0; n < 2; ++n) v[bj][n] = v[bj][n] * rstd * gn[bj][n];
                        if (do_rope) {
                            const float prow = (float)(4 * (j - 1) + 2 * ai + wr), pcol = (float)(16 * m + fr);
#pragma unroll
                            for (int bj = 0; bj < 2; ++bj)
#pragma unroll
                                for (int n = 0; n < 2; ++n)
#pragma unroll
                                    for (int i = 0; i < 4; ++i) { const float rev = (bj == 0 ? prow : pcol) * invr[n][i], frc = rev - floorf(rev);
                                        const float cs = __builtin_amdgcn_cosf(frc), sn = __builtin_amdgcn_sinf(frc), x = v[bj][n][i], pv = partner_xor32(x, (fq & 2) != 0);
                                        v[bj][n][i] = (fq & 2) ? (pv * sn + x * cs) : (x * cs - pv * sn); }
                        }
#pragma unroll
                        for (int bj = 0; bj < 2; ++bj)
#pragma unroll
                            for (int n = 0; n < 2; ++n) v[bj][n] = v[bj][n] * G.oscale;
                    }
                }
                bf16_t* rowp = O + (size_t)row * ldc + 64 * g + 8 * fq;
#pragma unroll
                for (int bj = 0; bj < 2; ++bj) { u32x4 w; w.x = cvtpk(v[bj][0][0], v[bj][0][1]); w.y = cvtpk(v[bj][0][2], v[bj][0][3]); w.z = cvtpk(v[bj][1][0], v[bj][1][1]); w.w = cvtpk(v[bj][1][2], v[bj][1][3]);
                    *(u32x4*)(rowp + 32 * bj) = w; }
            }
    }
};
template <bool BASE_F32, bool FINAL> struct EpiRes3 {
    static constexpr bool PERM = false, AFTER_DRAIN = false;
    const float* base_lat; const float* base_ctx; bf16_t* xr; float* out_lat; const float* modv_l; int chunk;
    bf16_t* xn; float* ssq; const float* gain_n; const float* modv_n; int chunk_n;
    __device__ __forceinline__ void operator()(const f32x4 (&acc)[2][2][4][2], const Unit& u, int wr, int wc, int fr, int fq) const {
        asm volatile("" : "+v"(fr), "+v"(fq) :: "memory");
        const int b = u.pm / 9, j = u.pm % 9; const int midx = (j == 0) ? 16 : b;
        const float* __restrict__ bp = (j == 0) ? base_ctx + (size_t)b * 256 * 1024 : base_lat + ((size_t)b * 2048 + (size_t)(j - 1) * 256) * 1024;
        float* __restrict__ op = out_lat + ((size_t)b * 2048 + (size_t)(j - 1) * 256) * 1024;
        bf16_t* __restrict__ xrp = xr + (size_t)u.pm * BM * 1024;
        bf16_t* __restrict__ xnp = xn + (size_t)u.pm * BM * 1024;
        const float* gv = modv_l + midx * 6144 + chunk * 1024; const float* sv = modv_n + midx * 6144 + chunk_n * 1024;
        const int rl0 = wr * 64 + fr, col0 = u.pn * BM + wc * 32 + 4 * fq;
        float ss[2][4];
#pragma unroll
        for (int ai = 0; ai < 2; ++ai)
#pragma unroll
            for (int m = 0; m < 4; ++m) ss[ai][m] = 0.f;
#pragma unroll
        for (int bj = 0; bj < 2; ++bj)
#pragma unroll
            for (int n = 0; n < 2; ++n) { const int col = col0 + bj * HALF + n * 16;
                const f32x4 g4v = *(const f32x4*)(gv + col);
                f32x4 gs4v = (f32x4){0.f, 0.f, 0.f, 0.f}; if (!FINAL) gs4v = *(const f32x4*)(gain_n + col) * (*(const f32x4*)(sv + col) + 1.0f);
                f32x4 bs[2][4];
#pragma unroll
                for (int ai = 0; ai < 2; ++ai)
#pragma unroll
                    for (int m = 0; m < 4; ++m) { const size_t ro = (size_t)(rl0 + ai * HALF + m * 16) * 1024 + col;
                        if (BASE_F32) bs[ai][m] = *(const f32x4*)(bp + ro);
                        else { const u32x2 w = *(const u32x2*)(xrp + ro); bs[ai][m] = (f32x4){__uint_as_float(w.x << 16), __uint_as_float(w.x & 0xffff0000u), __uint_as_float(w.y << 16), __uint_as_float(w.y & 0xffff0000u)}; } }
#pragma unroll
                for (int ai = 0; ai < 2; ++ai)
#pragma unroll
                    for (int m = 0; m < 4; ++m) { const size_t ro = (size_t)(rl0 + ai * HALF + m * 16) * 1024 + col;
                        const f32x4 x = bs[ai][m] + g4v * acc[ai][bj][m][n];
                        if (FINAL) *(f32x4*)(op + ro) = x;
                        else { u32x2 w; w.x = cvtpk(x[0], x[1]); w.y = cvtpk(x[2], x[3]); *(u32x2*)(xrp + ro) = w;
                            ss[ai][m] += (x[0] * x[0] + x[1] * x[1]) + (x[2] * x[2] + x[3] * x[3]);
                            const f32x4 h = x * gs4v; u32x2 w2; w2.x = cvtpk(h[0], h[1]); w2.y = cvtpk(h[2], h[3]);
                            *(u32x2*)(xnp + ro) = w2; } } }
        if (!FINAL) {
#pragma unroll
            for (int ai = 0; ai < 2; ++ai)
#pragma unroll
                for (int m = 0; m < 4; ++m) { const float s2 = sum_xor32(sum_xor16(ss[ai][m])); if (fq == 0) atomicAdd(ssq + u.pm * BM + rl0 + ai * HALF + m * 16, s2); } }
    }
};
struct EpiSwiGLU2 {
    static constexpr bool PERM = true, AFTER_DRAIN = false;
    bf16_t* H; const float* ssq_in; const float* shw;
    __device__ __forceinline__ void operator()(const f32x4 (&acc)[2][2][4][2], const Unit& u, int wr, int wc, int fr, int fq) const {
        asm volatile("" : "+v"(fr), "+v"(fq) :: "memory");
        const int b = u.pm / 9, j = u.pm % 9; const int midx = (j == 0) ? 16 : b;
        const int row0 = u.pm * BM + wr * 64 + fr, col0 = u.pn * HALF + wc * 32 + 8 * fq;
        const float* sp = shw + (size_t)midx * 5632 + u.pn * BM + wc * 32 + 8 * fq;
        const f32x4 sg0 = *(const f32x4*)(sp), sg1 = *(const f32x4*)(sp + 4), su0 = *(const f32x4*)(sp + HALF), su1 = *(const f32x4*)(sp + HALF + 4);
        float rinv[2][4];
#pragma unroll
        for (int ai = 0; ai < 2; ++ai)
#pragma unroll
            for (int m = 0; m < 4; ++m) rinv[ai][m] = 1.0f / sqrtf(ssq_in[row0 + ai * HALF + m * 16] * (1.0f / 1024.0f) + 1e-6f);
#pragma unroll
        for (int ai = 0; ai < 2; ++ai)
#pragma unroll
            for (int m = 0; m < 4; ++m) { const int row = row0 + ai * HALF + m * 16; bf16_t* rowp = H + (size_t)row * 3072 + col0;
                const float rin = rinv[ai][m];
                const f32x4 g0 = acc[ai][0][m][0] * rin + sg0, g1 = acc[ai][0][m][1] * rin + sg1, u0 = acc[ai][1][m][0] * rin + su0, u1 = acc[ai][1][m][1] * rin + su1;
                u32x4 w; w.x = cvtpk(silu_mul(g0[0], u0[0]), silu_mul(g0[1], u0[1])); w.y = cvtpk(silu_mul(g0[2], u0[2]), silu_mul(g0[3], u0[3]));
                w.z = cvtpk(silu_mul(g1[0], u1[0]), silu_mul(g1[1], u1[1])); w.w = cvtpk(silu_mul(g1[2], u1[2]), silu_mul(g1[3], u1[3]));
                *(u32x4*)rowp = w; }
    }
};

template <class Epi, class Sched, bool ALIGN_EPI = false, bool SP2 = false>
__device__ __forceinline__ void gemm_phase(PG8_LAS unsigned char* lds, const Gemm g, const Sched& S, const Epi& E) {
    const int tid = threadIdx.x, wid = __builtin_amdgcn_readfirstlane(tid >> 6), lane = tid & 63, wr = wid >> 2, wc = wid & 3, fr = lane & 15, fq = lane >> 4;
    const int K = g.K, nt = K / BK;
    unsigned voffA[2], voffB[2];
#pragma unroll
    for (int i = 0; i < 2; ++i) { int R, C; stage_rc(tid * 16 + i * 8192, R, C); const int Rb = Epi::PERM ? ((R & ~31) + perm32(R & 31)) : R;
        voffA[i] = (unsigned)(R * g.lda + C) * 2u; voffB[i] = (unsigned)(Rb * K + C) * 2u; }
    const size_t kstep = (size_t)(BK * 2);
    const size_t hstepB = (size_t)HALF * K * 2, hstepA = (size_t)HALF * g.lda * 2;
    const size_t tstepB = 2 * hstepB, tstepA = 2 * hstepA;
    const unsigned ldsw = (unsigned)wid * 1024u;
    const int aoff = lds_byte(wr * 64 + fr, fq * 8), boff = lds_byte(wc * 32 + fr, fq * 8);
#define PG8_SA(b, h) (((b) * 2 + (h)) * HTB)
#define PG8_SB(b, h) ((4 + (b) * 2 + (h)) * HTB)
#define PG8_STAGE(bufoff, gbase, voff) do { _Pragma("unroll") for (int _i = 0; _i < 2; ++_i) \
        __builtin_amdgcn_global_load_lds((const unsigned*)((const char*)(gbase) + (voff)[_i]), (PG8_LAS unsigned*)(lds + (bufoff) + ldsw + _i * 8192), 16, 0, 0); } while (0)
#define PG8_LDA(dst, b, h) do { _Pragma("unroll") for (int m = 0; m < 4; ++m) _Pragma("unroll") for (int k = 0; k < 2; ++k) dst[m][k] = *(const PG8_LAS bf16x8*)(lds + PG8_SA(b, h) + aoff + m * 2048 + k * 1024); } while (0)
#define PG8_LDB(dst, b, h) do { _Pragma("unroll") for (int n = 0; n < 2; ++n) _Pragma("unroll") for (int k = 0; k < 2; ++k) dst[n][k] = *(const PG8_LAS bf16x8*)(lds + PG8_SB(b, h) + boff + n * 2048 + k * 1024); } while (0)
#define PG8_MMA(ai, bj, At, Bt) do { __builtin_amdgcn_s_setprio(1); _Pragma("unroll") for (int m = 0; m < 4; ++m) _Pragma("unroll") for (int n = 0; n < 2; ++n) _Pragma("unroll") for (int k = 0; k < 2; ++k) \
        acc[ai][bj][m][n] = __builtin_amdgcn_mfma_f32_16x16x32_bf16(Bt[n][k], At[m][k], acc[ai][bj][m][n], 0, 0, 0); __builtin_amdgcn_s_setprio(0); } while (0)
#define PG8_WAIT_V(n) asm volatile("s_waitcnt vmcnt(" #n ")" ::: "memory")
#define PG8_WAIT_L(n) asm volatile("s_waitcnt lgkmcnt(" #n ")" ::: "memory")
#define PG8_BAR __builtin_amdgcn_s_barrier()
#define PG8_SCHED __builtin_amdgcn_sched_barrier(0)
    Unit cur, nxt; int ui = 0;
    if (!S.next(0, cur)) return;
    f32x4 acc[2][2][4][2];
#pragma unroll
    for (int a = 0; a < 2; ++a)
#pragma unroll
        for (int b = 0; b < 2; ++b)
#pragma unroll
            for (int m = 0; m < 4; ++m)
#pragma unroll
                for (int n = 0; n < 2; ++n) acc[a][b][m][n] = (f32x4){0.f, 0.f, 0.f, 0.f};
    bf16x8 At[4][2], B0[2][2], B1[2][2];
    const char* cA = (const char*)g.A + (size_t)cur.pm * tstepA + cur.aoff; const char* cB = (const char*)g.Bt + (size_t)cur.pn * tstepB;
    S.a_ready(cur);
    if constexpr (SP2) {
        PG8_STAGE(PG8_SB(0, 0), cB, voffB); PG8_STAGE(PG8_SB(0, 1), cB + hstepB, voffB); PG8_STAGE(PG8_SA(0, 0), cA, voffA); PG8_STAGE(PG8_SA(0, 1), cA + hstepA, voffA);
        if (wr == 1) PG8_BAR;
        PG8_WAIT_V(2); PG8_BAR;
        PG8_STAGE(PG8_SB(1, 0), cB + kstep, voffB); PG8_STAGE(PG8_SA(1, 0), cA + kstep, voffA); PG8_STAGE(PG8_SB(1, 1), cB + hstepB + kstep, voffB);
        PG8_WAIT_V(6); PG8_BAR;
    } else {
        PG8_STAGE(PG8_SB(0, 0), cB, voffB); PG8_STAGE(PG8_SA(0, 0), cA, voffA); PG8_STAGE(PG8_SB(0, 1), cB + hstepB, voffB); PG8_STAGE(PG8_SA(0, 1), cA + hstepA, voffA);
        if (wr == 1) PG8_BAR;
        PG8_WAIT_V(4); PG8_BAR;
        PG8_STAGE(PG8_SB(1, 0), cB + kstep, voffB); PG8_STAGE(PG8_SA(1, 0), cA + kstep, voffA); PG8_STAGE(PG8_SB(1, 1), cB + hstepB + kstep, voffB);
        PG8_WAIT_V(6); PG8_BAR;
    }
    for (;;) {
        const bool has_next = S.next(ui + 1, nxt);
        const char* nA = has_next ? (const char*)g.A + (size_t)nxt.pm * tstepA + nxt.aoff : cA; const char* nB = has_next ? (const char*)g.Bt + (size_t)nxt.pn * tstepB : cB;
        for (int t = 0; t < nt; t += 2) {
            const bool last = (t == nt - 2);
            const char* a1 = cA + (size_t)(t + 1) * kstep;
            const char* a2 = last ? nA : cA + (size_t)(t + 2) * kstep; const char* b2 = last ? nB : cB + (size_t)(t + 2) * kstep;
            const char* a3 = a2 + kstep; const char* b3 = b2 + kstep;
            if (last && has_next) S.a_ready(nxt);
            if constexpr (SP2) {
            PG8_LDB(B0, 0, 0); PG8_LDB(B1, 0, 1); PG8_SCHED; PG8_LDA(At, 0, 0); PG8_STAGE(PG8_SA(1, 1), a1 + hstepA, voffA);
            PG8_WAIT_V(8); PG8_WAIT_L(0); PG8_BAR; PG8_MMA(0, 0, At, B0); PG8_MMA(0, 1, At, B1); PG8_BAR; PG8_SCHED;
            PG8_LDA(At, 0, 1); PG8_STAGE(PG8_SB(0, 0), b2, voffB); PG8_STAGE(PG8_SB(0, 1), b2 + hstepB, voffB); PG8_STAGE(PG8_SA(0, 0), a2, voffA);
            PG8_WAIT_V(8); PG8_WAIT_L(0); PG8_BAR; PG8_MMA(1, 0, At, B0); PG8_MMA(1, 1, At, B1); PG8_BAR; PG8_SCHED;
            PG8_LDB(B0, 1, 0); PG8_LDB(B1, 1, 1); PG8_SCHED; PG8_LDA(At, 1, 0); PG8_STAGE(PG8_SA(0, 1), a2 + hstepA, voffA);
            PG8_WAIT_V(8); PG8_WAIT_L(0); PG8_BAR; PG8_MMA(0, 0, At, B0); PG8_MMA(0, 1, At, B1); PG8_BAR; PG8_SCHED;
            PG8_LDA(At, 1, 1); PG8_STAGE(PG8_SB(1, 0), b3, voffB); PG8_STAGE(PG8_SB(1, 1), b3 + hstepB, voffB); PG8_STAGE(PG8_SA(1, 0), a3, voffA);
            PG8_WAIT_V(8); PG8_WAIT_L(0); PG8_BAR; PG8_MMA(1, 0, At, B0); PG8_MMA(1, 1, At, B1); PG8_BAR; PG8_SCHED;
            } else {
            PG8_LDB(B0, 0, 0); PG8_SCHED; PG8_LDA(At, 0, 0); PG8_STAGE(PG8_SA(1, 1), a1 + hstepA, voffA);
            PG8_WAIT_L(8); PG8_BAR; PG8_WAIT_L(0); PG8_MMA(0, 0, At, B0); PG8_BAR; PG8_SCHED;
            PG8_LDB(B1, 0, 1); PG8_STAGE(PG8_SB(0, 0), b2, voffB);
            PG8_BAR; PG8_WAIT_L(0); PG8_MMA(0, 1, At, B1); PG8_BAR;
            PG8_LDA(At, 0, 1); PG8_STAGE(PG8_SA(0, 0), a2, voffA);
            PG8_BAR; PG8_WAIT_L(0); PG8_MMA(1, 0, At, B0); PG8_BAR; PG8_SCHED;
            PG8_STAGE(PG8_SB(0, 1), b2 + hstepB, voffB);
            PG8_WAIT_V(6); PG8_BAR; PG8_MMA(1, 1, At, B1); PG8_BAR;
            PG8_LDB(B0, 1, 0); PG8_SCHED; PG8_LDA(At, 1, 0); PG8_STAGE(PG8_SA(0, 1), a2 + hstepA, voffA);
            PG8_WAIT_L(8); PG8_BAR; PG8_WAIT_L(0); PG8_MMA(0, 0, At, B0); PG8_BAR; PG8_SCHED;
            PG8_LDB(B1, 1, 1); PG8_STAGE(PG8_SB(1, 0), b3, voffB);
            PG8_BAR; PG8_WAIT_L(0); PG8_MMA(0, 1, At, B1); PG8_BAR;
            PG8_LDA(At, 1, 1); PG8_STAGE(PG8_SA(1, 0), a3, voffA);
            PG8_BAR; PG8_WAIT_L(0); PG8_MMA(1, 0, At, B0); PG8_BAR; PG8_SCHED;
            PG8_STAGE(PG8_SB(1, 1), b3 + hstepB, voffB);
            PG8_WAIT_V(6); PG8_BAR; PG8_MMA(1, 1, At, B1); PG8_BAR;
            }
        }
        if constexpr (ALIGN_EPI) { if (wr == 0) PG8_BAR; }
        if constexpr (!Epi::AFTER_DRAIN) { E(acc, cur, wr, wc, fr, fq); S.done(cur); }
        if (!has_next) break;
#pragma unroll
        for (int a = 0; a < 2; ++a)
#pragma unroll
            for (int b = 0; b < 2; ++b)
#pragma unroll
                for (int m = 0; m < 4; ++m)
#pragma unroll
                    for (int n = 0; n < 2; ++n) acc[a][b][m][n] = (f32x4){0.f, 0.f, 0.f, 0.f};
        cur = nxt; cA = nA; cB = nB; ++ui;
        if constexpr (ALIGN_EPI) { if (wr == 1) PG8_BAR; }
    }
    PG8_WAIT_V(0);
    if constexpr (!ALIGN_EPI) { if (wr == 0) PG8_BAR; }
    PG8_BAR;
    if constexpr (Epi::AFTER_DRAIN) { E.fused(acc, cur, wr, wc, fr, fq, lds, wid, lane); S.done(cur); }
#undef PG8_SA
#undef PG8_SB
#undef PG8_STAGE
#undef PG8_LDA
#undef PG8_LDB
#undef PG8_MMA
#undef PG8_WAIT_V
#undef PG8_WAIT_L
#undef PG8_BAR
#undef PG8_SCHED
}
}

constexpr int DM = 1024, NBATCH = 16, SEQ = 2048, CTXL = 256, TU = SEQ + CTXL  , MROWS = NBATCH * TU  ;
constexpr int EVN = 1984, EVNP = 2048, DFF = 2816, ODN = 3072, HIDP = 3072  ;
constexpr float EPS = 1e-6f, LOG2E = 1.4426950408889634f;
constexpr float QS_DA = 0.125f * LOG2E, QS_NA = 0.125f * LOG2E, QS_MLA = 0.07216878364870322f * LOG2E;
constexpr float LAM_INIT0 = 0.2f;

constexpr size_t MiB = 1u << 20;
constexpr size_t WS_CTL = 0, CTL_ZERO_BYTES = 1 * MiB;
constexpr size_t WS_MODV = 1 * MiB;
constexpr size_t WS_SMALL = 2 * MiB;
constexpr size_t WS_SSQ = WS_SMALL + 65536, SSQ_STRIDE = 163840;
constexpr size_t WS_WUQ = 3 * MiB;
constexpr size_t WS_WUKV = WS_WUQ + 768 * 256 * 2;
constexpr size_t WS_WEV = 5 * MiB;
constexpr size_t WS_WO = 9 * MiB;
constexpr size_t WS_WOD = 13 * MiB;
constexpr size_t WS_WFI = 19 * MiB;
constexpr size_t WS_WFO = 41 * MiB;
constexpr size_t WS_XR16 = 53 * MiB;
constexpr size_t WS_XN = 125 * MiB;
constexpr size_t WS_KVRAW = WS_XN;
constexpr size_t WS_Y = 197 * MiB;
constexpr size_t WS_REG = 269 * MiB;
constexpr size_t WS_QRAW = WS_REG + 144 * MiB;
constexpr size_t WS_SHW = 485 * MiB;
constexpr size_t SHW_F0 = 0, SHW_OD = 17 * 5632 * 4, SHW_F1 = SHW_OD + 17 * 3072 * 4;
constexpr size_t WS_END = 487 * MiB;

constexpr int LDS_BYTES = 147456;
#define LAS __attribute__((address_space(3)))
typedef unsigned short bf16_t;
typedef unsigned u32x4 __attribute__((ext_vector_type(4)));
typedef unsigned u32x2 __attribute__((ext_vector_type(2)));
typedef float f32x4 __attribute__((ext_vector_type(4)));
typedef float f32x16 __attribute__((ext_vector_type(16)));
typedef short bf16x8 __attribute__((ext_vector_type(8)));
typedef short s16x4 __attribute__((ext_vector_type(4)));
using pg8::cvtpk;

struct Params {
    const float* in[30];
    float* out; unsigned char* ws;
    int ph_lo, ph_hi, abl, pad;
};
struct Frame {
    LAS unsigned char* lds;
    int tid, lane, wave, G, bid, abl;
    float* out; unsigned char* ws;
};
__device__ __forceinline__ const float* inptr(const Params& p, int i) { asm volatile("" : "+s"(i)); return p.in[i]; }
#define INP(i) inptr(p, (i))
#define IN_X 0
#define IN_C 1
#define IN_CTX 2
#define IN_CCTX 3
#define IN_MODW 4
#define IN_MODB 5
#define IN_NMIX 6
#define IN_NFFN 7
#define IN_WOUT 8
#define IN_FWIN 9
#define IN_FWOUT 10
#define IN_EVW 11
#define IN_DAQG 12
#define IN_DAKG 13
#define IN_LQ1 14
#define IN_LK1 15
#define IN_LQ2 16
#define IN_LK2 17
#define IN_DAOG 18
#define IN_MQAG 19
#define IN_WUQ 20
#define IN_MKVAG 21
#define IN_WUKV 22
#define IN_MQG 23
#define IN_MKG 24
#define IN_MKRG 25
#define IN_ODW 26
#define IN_NAQG 27
#define IN_NAKG 28
#define IN_RPB 29

__device__ __forceinline__ float wave_sum(float v) { return pg8::wave_sum_fast(v); }
__device__ __forceinline__ float bf_lo(unsigned w) { return __uint_as_float(w << 16); }
__device__ __forceinline__ float bf_hi(unsigned w) { return __uint_as_float(w & 0xffff0000u); }
__device__ __forceinline__ void unpack8(const u32x4 w, float (&v)[8]) { v[0] = bf_lo(w.x); v[1] = bf_hi(w.x); v[2] = bf_lo(w.y); v[3] = bf_hi(w.y); v[4] = bf_lo(w.z); v[5] = bf_hi(w.z); v[6] = bf_lo(w.w); v[7] = bf_hi(w.w); }
__device__ __forceinline__ u32x4 pack8(const float (&v)[8]) { u32x4 w; w.x = cvtpk(v[0], v[1]); w.y = cvtpk(v[2], v[3]); w.z = cvtpk(v[4], v[5]); w.w = cvtpk(v[6], v[7]); return w; }
#define LDS_WAIT() asm volatile("s_waitcnt lgkmcnt(0)" ::: "memory")

__device__ __forceinline__ void transpose_item(const float* W, int N, bf16_t* WT, int ldt, int dst_row, int k0, int n0, const float* kscale, LAS float* scr, int lane) {
    float tv[32];
    { const float* wp = W + (size_t)(k0 + (lane >> 5)) * N + n0 + (lane & 31);
#pragma unroll
      for (int i = 0; i < 32; ++i) tv[i] = wp[(size_t)(2 * i) * N]; }
    if (kscale) { const float* kp = kscale + k0 + (lane >> 5);
#pragma unroll
      for (int i = 0; i < 32; ++i) tv[i] *= kp[2 * i]; }
#pragma unroll
    for (int i = 0; i < 32; ++i) scr[(2 * i + (lane >> 5)) * 33 + (lane & 31)] = tv[i];
    LDS_WAIT(); asm volatile("" ::: "memory");
    const int c = lane & 7;
#pragma unroll
    for (int j = 0; j < 4; ++j) { const int n = (lane >> 3) + 8 * j; const LAS float* s = scr + (8 * c) * 33 + n;
        u32x4 o; o.x = cvtpk(s[0 * 33], s[1 * 33]); o.y = cvtpk(s[2 * 33], s[3 * 33]); o.z = cvtpk(s[4 * 33], s[5 * 33]); o.w = cvtpk(s[6 * 33], s[7 * 33]);
        *(u32x4*)(WT + (size_t)(dst_row + n) * ldt + k0 + 8 * c) = o; }
    LDS_WAIT(); asm volatile("" ::: "memory");
}
__host__ __device__ __forceinline__ int head_row(int L) { return 256 * (L / 256) + 128 * ((L % 64) / 32) + 32 * ((L % 256) / 64); }
__device__ __forceinline__ void p0_prologue(Frame& F, const Params& p) {
    float* modv = (float*)(F.ws + WS_MODV);
    LAS float* condl = (LAS float*)F.lds;
    LAS float* red = (LAS float*)(F.lds + 17 * 1024 * 4);
    for (int e = F.tid; e < 17 * 1024; e += 512) { const int i = e >> 10, k = e & 1023; const float c = (i < 16) ? INP(IN_C)[i * 1024 + k] : INP(IN_CCTX)[k]; condl[e] = c / (1.0f + __expf(-c)); }
    __syncthreads();
    for (int item = F.bid; item < 256; item += F.G) {
        const int l = item >> 7, cg_ = item & 127, col = cg_ * 48 + (F.lane < 48 ? F.lane : 0);
        float acc[17];
#pragma unroll
        for (int i = 0; i < 17; ++i) acc[i] = 0.f;
        const float* wp = INP(IN_MODW) + ((size_t)l * 1024 + F.wave * 128) * 6144 + col;
        const LAS float* cl = condl + F.wave * 128;
#pragma unroll 8
        for (int k = 0; k < 128; ++k) { const float wv = wp[(size_t)k * 6144];
#pragma unroll
            for (int i = 0; i < 17; ++i) acc[i] += cl[i * 1024 + k] * wv; }
        if (F.lane < 48) {
#pragma unroll
            for (int i = 0; i < 17; ++i) red[(F.wave * 17 + i) * 48 + F.lane] = acc[i]; }
        __syncthreads();
        for (int t = F.tid; t < 17 * 48; t += 512) { const int i = t / 48, cl2 = t % 48; float s = 0.f;
#pragma unroll
            for (int w = 0; w < 8; ++w) s += red[(w * 17 + i) * 48 + cl2];
            modv[((size_t)l * 17 + i) * 6144 + cg_ * 48 + cl2] = s + INP(IN_MODB)[l * 6144 + cg_ * 48 + cl2]; }
        __syncthreads();
    }
    { float* z = (float*)(F.ws + WS_SSQ); for (int e = F.bid * 512 + F.tid; e < (int)(5 * SSQ_STRIDE / 4); e += F.G * 512) z[e] = 0.f; }
    { const int gt = F.bid * 512 + F.tid; if (gt < 1024) { const int pos = gt >> 4, f = gt & 15; const float inv = __builtin_amdgcn_exp2f(-(float)f * 0.8304820237218405f);
          const float rev = (float)pos * inv * 0.15915494309189535f, fr = rev - floorf(rev);
          float* rt = (float*)(F.ws + WS_SMALL); rt[2 * gt] = __builtin_amdgcn_cosf(fr); rt[2 * gt + 1] = __builtin_amdgcn_sinf(fr); } }
    LAS float* scr = (LAS float*)(F.lds + F.wave * 16384);
    const int gw = F.bid * 8 + F.wave, NGW = F.G * 8;
    constexpr int I_EV = 16 * 62, I_O = 16 * 32, I_FI = 16 * 176, I_FO = 44 * 32, I_OD = 16 * 96, I_UQ = 4 * 24, I_UKV = 2 * 32;
    constexpr int NITEMS = I_EV + 2 * I_O + 2 * I_FI + 2 * I_FO + I_OD + I_UQ + I_UKV;
    for (int it = gw; it < NITEMS; it += NGW) {
        int r = it;
        if (r < I_EV) { const int kb = r / 62, nb = r % 62; transpose_item(INP(IN_EVW), EVN, (bf16_t*)(F.ws + WS_WEV), 1024, head_row(32 * nb), 64 * kb, 32 * nb, nullptr, scr, F.lane); continue; } r -= I_EV;
        if (r < 2 * I_O) { const int l = r / I_O; r %= I_O; const int kb = r / 32, nb = r % 32; transpose_item(INP(IN_WOUT) + (size_t)l * 1024 * 1024, 1024, (bf16_t*)(F.ws + WS_WO) + (size_t)l * 1024 * 1024, 1024, 32 * nb, 64 * kb, 32 * nb, nullptr, scr, F.lane); continue; } r -= 2 * I_O;
        if (r < 2 * I_FI) { const int l = r / I_FI; r %= I_FI; const int kb = r / 176, nb = r % 176; const int n0 = 32 * nb, up = n0 >= DFF ? 1 : 0, jj = n0 - up * DFF;
            const int drow = (jj / 128) * 256 + up * 128 + (jj % 128);
            transpose_item(INP(IN_FWIN) + (size_t)l * 1024 * 5632, 5632, (bf16_t*)(F.ws + WS_WFI) + (size_t)l * 5632 * 1024, 1024, drow, 64 * kb, n0, nullptr, scr, F.lane); continue; } r -= 2 * I_FI;
        if (r < 2 * I_FO) { const int l = r / I_FO; r %= I_FO; const int kb = r / 32, nb = r % 32; transpose_item(INP(IN_FWOUT) + (size_t)l * DFF * 1024, 1024, (bf16_t*)(F.ws + WS_WFO + (size_t)l * 6 * MiB), DFF, 32 * nb, 64 * kb, 32 * nb, nullptr, scr, F.lane); continue; } r -= 2 * I_FO;
        if (r < I_OD) { const int kb = r / 96, nb = r % 96; transpose_item(INP(IN_ODW), ODN, (bf16_t*)(F.ws + WS_WOD), 1024, head_row(32 * nb), 64 * kb, 32 * nb, nullptr, scr, F.lane); continue; } r -= I_OD;
        if (r < I_UQ) { const int kb = r / 24, nb = r % 24; transpose_item(INP(IN_WUQ), 768, (bf16_t*)(F.ws + WS_WUQ), 256, 32 * nb, 64 * kb, 32 * nb, INP(IN_MQAG), scr, F.lane); continue; } r -= I_UQ;
        { const int kb = r / 32, nb = r % 32; transpose_item(INP(IN_WUKV), 1024, (bf16_t*)(F.ws + WS_WUKV), 256, 32 * nb, 64 * kb, 32 * nb, INP(IN_MKVAG), scr, F.lane); }
    }
}

__device__ __forceinline__ void norm_pass(Frame& F, const Params& p, int layer, const float* gain, int ch_sh, int ch_sc, bool from_inputs, bool latent_only) {
    const float* modv = (const float*)(F.ws + WS_MODV) + (size_t)layer * 17 * 6144;
    bf16_t* XN = (bf16_t*)(F.ws + WS_XN);
    const int gw = F.bid * 8 + F.wave, NGW = F.G * 8;
    for (int chunk = gw; chunk < MROWS / 18; chunk += NGW) {
        int cur = -1; f32x4 gs[4], shv[4];
        for (int r0 = 0; r0 < 18; r0 += 3) {
            f32x4 v[3][4];
#pragma unroll
            for (int q = 0; q < 3; ++q) {
                const int R = chunk * 18 + r0 + q, b = R / TU, t = R % TU; const bool isc = t < CTXL;
                const float* src;
                if (from_inputs) src = isc ? INP(IN_CTX) + ((size_t)b * CTXL + t) * 1024 : INP(IN_X) + ((size_t)b * SEQ + (t - CTXL)) * 1024;
                else src = F.out + ((size_t)b * SEQ + (isc ? 0 : t - CTXL)) * 1024;
#pragma unroll
                for (int j = 0; j < 4; ++j) v[q][j] = *(const f32x4*)(src + 256 * j + 4 * F.lane);
            }
#pragma unroll
            for (int q = 0; q < 3; ++q) {
                const int R = chunk * 18 + r0 + q, b = R / TU, t = R % TU; const bool isc = t < CTXL;
                if (latent_only && isc) continue;
                const int midx = isc ? 16 : b;
                if (midx != cur) { cur = midx; const float* mv = modv + (size_t)midx * 6144;
#pragma unroll
                    for (int j = 0; j < 4; ++j) { const f32x4 g4 = *(const f32x4*)(gain + 256 * j + 4 * F.lane), sc4 = *(const f32x4*)(mv + ch_sc * 1024 + 256 * j + 4 * F.lane);
                        gs[j] = g4 * (sc4 + 1.0f); shv[j] = *(const f32x4*)(mv + ch_sh * 1024 + 256 * j + 4 * F.lane); } }
                float ss = 0.f;
#pragma unroll
                for (int j = 0; j < 4; ++j) ss += (v[q][j].x * v[q][j].x + v[q][j].y * v[q][j].y) + (v[q][j].z * v[q][j].z + v[q][j].w * v[q][j].w);
                const float rstd = 1.0f / sqrtf(wave_sum(ss) * (1.0f / 1024.0f) + EPS);
#pragma unroll
                for (int j = 0; j < 4; ++j) { const f32x4 h = v[q][j] * rstd * gs[j] + shv[j]; u32x2 w; w.x = cvtpk(h.x, h.y); w.y = cvtpk(h.z, h.w);
                    *(u32x2*)(XN + (size_t)R * 1024 + 256 * j + 4 * F.lane) = w; }
            }
        }
    }
}

__device__ __forceinline__ void shw_pass(Frame& F) {
    const float* modv = (const float*)(F.ws + WS_MODV);
    const int gw = F.bid * 8 + F.wave, NGW = F.G * 8, lane = F.lane;
    for (int it = gw; it < 5632 + 3072 + 5632; it += NGW) {
        const bf16_t* wt; const float* sh; float* dst; int n, ld;
        if (it < 5632) { n = it; wt = (const bf16_t*)(F.ws + WS_WFI); sh = modv + 3 * 1024; dst = (float*)(F.ws + WS_SHW + SHW_F0); ld = 5632; }
        else if (it < 5632 + 3072) { n = it - 5632; wt = (const bf16_t*)(F.ws + WS_WOD); sh = modv + 17 * 6144; dst = (float*)(F.ws + WS_SHW + SHW_OD); ld = 3072; }
        else { n = it - 5632 - 3072; wt = (const bf16_t*)(F.ws + WS_WFI) + (size_t)5632 * 1024; sh = modv + 17 * 6144 + 3 * 1024; dst = (float*)(F.ws + WS_SHW + SHW_F1); ld = 5632; }
        float wv[16]; { float a[8], b2[8]; unpack8(*(const u32x4*)(wt + (size_t)n * 1024 + 16 * lane), a); unpack8(*(const u32x4*)(wt + (size_t)n * 1024 + 16 * lane + 8), b2);
#pragma unroll
            for (int e = 0; e < 8; ++e) { wv[e] = a[e]; wv[8 + e] = b2[e]; } }
        float acc[17];
#pragma unroll
        for (int i = 0; i < 17; ++i) { const float* sp = sh + (size_t)i * 6144 + 16 * lane; float s2 = 0.f;
#pragma unroll
            for (int q = 0; q < 4; ++q) { const f32x4 x = *(const f32x4*)(sp + 4 * q); s2 += (x[0] * wv[4 * q] + x[1] * wv[4 * q + 1]) + (x[2] * wv[4 * q + 2] + x[3] * wv[4 * q + 3]); }
            acc[i] = s2; }
        { const bool b5 = (lane & 32) != 0, b4 = (lane & 16) != 0, b3 = (lane & 8) != 0, b2 = (lane & 4) != 0;
          float w8[8], w4[4], w2[2], z;
#pragma unroll
          for (int q = 0; q < 8; ++q) { const float snd = b5 ? acc[q] : acc[8 + q], kp = b5 ? acc[8 + q] : acc[q]; w8[q] = kp + __shfl_xor(snd, 32); }
#pragma unroll
          for (int q = 0; q < 4; ++q) { const float snd = b4 ? w8[q] : w8[4 + q], kp = b4 ? w8[4 + q] : w8[q]; w4[q] = kp + __shfl_xor(snd, 16); }
#pragma unroll
          for (int q = 0; q < 2; ++q) { const float snd = b3 ? w4[q] : w4[2 + q], kp = b3 ? w4[2 + q] : w4[q]; w2[q] = kp + __shfl_xor(snd, 8); }
          { const float snd = b2 ? w2[0] : w2[1], kp = b2 ? w2[1] : w2[0]; z = kp + __shfl_xor(snd, 4); }
          z += __shfl_xor(z, 2); z += __shfl_xor(z, 1);
          const int idx = (b5 ? 8 : 0) + (b4 ? 4 : 0) + (b3 ? 2 : 0) + (b2 ? 1 : 0);
          if ((lane & 3) == 0) dst[(size_t)idx * ld + n] = z;
          const float s16 = wave_sum(acc[16]); if (lane == 0) dst[(size_t)16 * ld + n] = s16; }
    }
}

__device__ __forceinline__ void group64_norm(float (&v)[8], const float* gain, bool rope, int prow, int pcol, const float* ropet, float oscale, int lane) {
    float ss = 0.f;
#pragma unroll
    for (int e = 0; e < 8; ++e) ss += v[e] * v[e];
    ss += __shfl_xor(ss, 1); ss += __shfl_xor(ss, 2); ss += __shfl_xor(ss, 4);
    const float rstd = 1.0f / sqrtf(ss * (1.0f / 64.0f) + EPS);
    const int u = lane & 7;
#pragma unroll
    for (int e = 0; e < 8; ++e) v[e] *= rstd * gain[8 * u + e];
    float pv[8];
#pragma unroll
    for (int e = 0; e < 8; ++e) pv[e] = __shfl_xor(v[e], 2);
    if (rope) { const int pos = (u & 4) ? pcol : prow; const float* rt = ropet + (pos * 16 + 8 * (u & 1)) * 2;
#pragma unroll
        for (int e = 0; e < 8; ++e) { const float cs = rt[2 * e], sn = rt[2 * e + 1]; v[e] = (u & 2) ? (pv[e] * sn + v[e] * cs) : (v[e] * cs - pv[e] * sn); } }
#pragma unroll
    for (int e = 0; e < 8; ++e) v[e] *= oscale;
}
__device__ __forceinline__ void post_proj0(Frame& F, const Params& p) {
    bf16_t* PROJ = (bf16_t*)(F.ws + WS_REG);
    const float* ropet = (const float*)(F.ws + WS_SMALL);
    float* rcq = (float*)(F.ws + WS_SMALL + 65536); float* rckv = (float*)(F.ws + WS_SMALL + 262144);
    const int gw = F.bid * 8 + F.wave, NGW = F.G * 8, lane = F.lane;
    for (int chunk = gw; chunk < MROWS / 18; chunk += NGW)
        for (int r = 0; r < 18; ++r) {
            const int R = chunk * 18 + r, t = R % TU; const bool lat = t >= CTXL; const int tl = lat ? t - CTXL : 0, prow = tl >> 6, pcol = tl & 63;
            bf16_t* rowp = PROJ + (size_t)R * 2048;
#pragma unroll
            for (int ci = 0; ci < 2; ++ci) { float v[8]; unpack8(*(const u32x4*)(rowp + 512 * ci + 8 * lane), v);
                group64_norm(v, ci == 0 ? INP(IN_DAQG) : INP(IN_DAKG), lat, prow, pcol, ropet, ci == 0 ? QS_DA : 1.0f, lane);
                *(u32x4*)(rowp + 512 * ci + 8 * lane) = pack8(v); }
            { float v[8]; unpack8(*(const u32x4*)(rowp + 1536 + 8 * lane), v);
              float ss = 0.f;
#pragma unroll
              for (int e = 0; e < 8; ++e) ss += v[e] * v[e];
              ss += __shfl_xor(ss, 1); ss += __shfl_xor(ss, 2); ss += __shfl_xor(ss, 4);
              const float s8 = ss; const float s16 = s8 + __shfl_xor(s8, 8); const float s32 = s16 + __shfl_xor(s16, 16);
              if (lane == 0) rcq[R] = 1.0f / sqrtf(s32 * (1.0f / 256.0f) + EPS);
              if (lane == 32) rckv[R] = 1.0f / sqrtf(s16 * (1.0f / 128.0f) + EPS);
              group64_norm(v, INP(IN_MKRG), lat, prow, pcol, ropet, 1.0f, lane);
              if (lane >= 48 && lane < 56) *(u32x4*)(rowp + 1536 + 8 * lane) = pack8(v); }
        }
}
__device__ __forceinline__ void post_up0(Frame& F, const Params& p) {
    bf16_t* KVRAW = (bf16_t*)(F.ws + WS_KVRAW);
    const int gw = F.bid * 8 + F.wave, NGW = F.G * 8, lane = F.lane, l32 = lane & 31, head = l32 >> 3, sub = l32 & 7;
    const float* g = INP(IN_MKG) + 16 * sub;
    float gn[16];
#pragma unroll
    for (int e = 0; e < 16; ++e) gn[e] = g[e];
    for (int chunk = gw; chunk < MROWS / 18; chunk += NGW)
        for (int r0 = 0; r0 < 18; r0 += 6) {
            u32x4 ra[3], rb[3];
#pragma unroll
            for (int q = 0; q < 3; ++q) { const int R = chunk * 18 + r0 + 2 * q + (lane >> 5); const bf16_t* rowp = KVRAW + (size_t)R * 1024 + 256 * head + 16 * sub;
                ra[q] = *(const u32x4*)(rowp); rb[q] = *(const u32x4*)(rowp + 8); }
#pragma unroll
            for (int q = 0; q < 3; ++q) { const int R = chunk * 18 + r0 + 2 * q + (lane >> 5); bf16_t* rowp = KVRAW + (size_t)R * 1024 + 256 * head + 16 * sub;
                float a[8], b[8]; unpack8(ra[q], a); unpack8(rb[q], b);
                float ss = 0.f;
#pragma unroll
                for (int e = 0; e < 8; ++e) ss += a[e] * a[e] + b[e] * b[e];
                ss += __shfl_xor(ss, 1); ss += __shfl_xor(ss, 2); ss += __shfl_xor(ss, 4);
                const float rn = 1.0f / sqrtf(ss * (1.0f / 128.0f) + EPS);
#pragma unroll
                for (int e = 0; e < 8; ++e) { a[e] *= rn * gn[e]; b[e] *= rn * gn[8 + e]; }
                *(u32x4*)(rowp) = pack8(a); *(u32x4*)(rowp + 8) = pack8(b); }
        }
}
__device__ __forceinline__ void post_proj1(Frame& F, const Params& p) {
    bf16_t* P1 = (bf16_t*)(F.ws + WS_REG);
    const int gw = F.bid * 8 + F.wave, NGW = F.G * 8, lane = F.lane;
    for (int chunk = gw; chunk < MROWS / 18; chunk += NGW)
        for (int r = 0; r < 18; ++r) {
            const int R = chunk * 18 + r; bf16_t* rowp = P1 + (size_t)R * ODN;
#pragma unroll
            for (int ci = 0; ci < 4; ++ci) { float v[8]; unpack8(*(const u32x4*)(rowp + 512 * ci + 8 * lane), v);
                group64_norm(v, ci < 2 ? INP(IN_NAQG) : INP(IN_NAKG), false, 0, 0, nullptr, ci < 2 ? QS_NA : 1.0f, lane);
                *(u32x4*)(rowp + 512 * ci + 8 * lane) = pack8(v); }
        }
}

#ifndef USE_TR
#define USE_TR 1
#endif
template <int MODE> struct ACfg;
template <> struct ACfg<0> { static constexpr int DQK = 192, DV = 128, NKROWS = 64; };
template <> struct ACfg<1> { static constexpr int DQK = 64, DV = 128, NKROWS = 128; };
template <> struct ACfg<2> { static constexpr int DQK = 64, DV = 64, NKROWS = 64; };
__device__ __forceinline__ int crow(int r, int hi) { return (r & 3) + 8 * (r >> 2) + 4 * hi; }
__device__ __forceinline__ bf16x8 pack8f(float a0, float a1, float a2, float a3, float a4, float a5, float a6, float a7) {
    u32x4 w; w.x = cvtpk(a0, a1); w.y = cvtpk(a2, a3); w.z = cvtpk(a4, a5); w.w = cvtpk(a6, a7); return __builtin_bit_cast(bf16x8, w); }
typedef short v4i16_t __attribute__((ext_vector_type(4)));

struct AttnArgs {
    const bf16_t* q; int q_pitch;
    const bf16_t* kA; int kA_pitch;
    const bf16_t* kB; int kB_pitch;
    const bf16_t* v; int v_pitch;
    int nt;
    int klo;
    int r0;
    const float* qg; const float* ropet; int qt0;
};

__device__ __forceinline__ void glds16(const void* gsrc, unsigned lds_dst) { unsigned keep;
    asm volatile("s_mov_b32 %0, m0\n\ts_mov_b32 m0, %2\n\ts_nop 0\n\tglobal_load_lds_dwordx4 %1, off\n\ts_mov_b32 m0, %0" : "=&s"(keep) : "v"(gsrc), "s"(lds_dst) : "memory"); }
__device__ __forceinline__ float max3f(float a, float b, float c) { float r; asm("v_max3_f32 %0, %1, %2, %3" : "=v"(r) : "v"(a), "v"(b), "v"(c)); return r; }
__device__ __forceinline__ float max2f(float a, float b) { float r; asm("v_max_f32_e32 %0, %1, %2" : "=v"(r) : "v"(a), "v"(b)); return r; }
template <int MODE, int ABL = 0, bool XS = false>
__device__ __forceinline__ void attn_core(LAS unsigned char* lds, const AttnArgs& A, f32x16 (&o)[ACfg<MODE>::DV / 32], float& linv, const LAS float* rpbl, bf16x8 (&qf)[ACfg<MODE>::DQK / 16], bool pre = false, bool has_next = false) {
    constexpr int DQK = ACfg<MODE>::DQK, DV = ACfg<MODE>::DV;
    constexpr int NIMG = (MODE == 0) ? 3 : (MODE == 1 ? 2 : 1), KBYTES = NIMG * 8192, VBYTES = 64 * DV * 2, STG = KBYTES + VBYTES, KPT = NIMG, VPT = DV / 64, PT = KPT + VPT;
    constexpr int DIST = (MODE == 2) ? 3 : 2, NSLOT = DIST + 1;
    static_assert(NSLOT * STG <= 131072, "attention tile geometry");
    const int tid = threadIdx.x, lane = tid & 63, r32 = lane & 31, hi = lane >> 5, w = __builtin_amdgcn_readfirstlane(tid >> 6);
    const int comp = (MODE == 1) ? (w >> 2) : 0, grp = (MODE == 2) ? 0 : (w >> 2);
    int qrow_idx; int rs_w = 0, rq = 0, cq = 0;
    if (MODE == 0) qrow_idx = 32 * w + r32;
    else if (MODE == 1) qrow_idx = 32 * (w & 3) + r32;
    else { rq = A.r0 + (w >> 1); cq = 32 * (w & 1) + r32; qrow_idx = (w >> 1) * 64 + cq; rs_w = rq - 4 < 0 ? 0 : (rq - 4 > 24 ? 24 : rq - 4); }
    const bf16_t* qrow = A.q + (size_t)qrow_idx * A.q_pitch + (MODE == 1 ? 64 * comp : 0);
#pragma unroll
    for (int d = 0; d < DV / 32; ++d) o[d] = (f32x16){0.f, 0.f, 0.f, 0.f, 0.f, 0.f, 0.f, 0.f, 0.f, 0.f, 0.f, 0.f, 0.f, 0.f, 0.f, 0.f};
    float lsum = 0.f;
    const int cs_q = (MODE == 2) ? (cq - 8 < 0 ? 0 : (cq - 8 > 48 ? 48 : cq - 8)) : 0;
    unsigned vm0 = 0u, vm1 = 0u;
    if (MODE == 2) {
#pragma unroll
        for (int r = 0; r < 16; ++r) { const int kc = crow(r, hi); vm0 |= ((unsigned)(kc - cs_q) < 16u ? 1u : 0u) << r; vm1 |= ((unsigned)(kc + 32 - cs_q) < 16u ? 1u : 0u) << r; } }
    unsigned koff[KPT], voff[VPT];
    { const int row = 8 * w + (lane >> 3), sc = (lane & 7) ^ ((row >> 1) & 7);
#pragma unroll
      for (int i = 0; i < KPT; ++i) {
        if (MODE == 0) koff[i] = (i < 2) ? (unsigned)(row * A.kA_pitch + 64 * i + sc * 8) * 2u : (unsigned)(row * A.kB_pitch + sc * 8) * 2u;
        else koff[i] = (unsigned)(row * A.kA_pitch + sc * 8) * 2u;
      } }
#pragma unroll
    for (int i = 0; i < VPT; ++i) { const int pc = w + 8 * i, dblk = pc >> 2, rg = pc & 3; voff[i] = (unsigned)((16 * rg + (lane >> 2)) * A.v_pitch + 32 * dblk + (lane & 3) * 8) * 2u; }
#define TILE_T0(tile) ((MODE == 2) ? ((tile) < 4 ? 64 * (tile) : CTXL + 64 * (A.klo + (tile) - 4)) : 64 * (tile))
#define DMA_TILE(tile, slotoff) do { const int t0_ = TILE_T0(tile); \
        const char* kAb_ = (const char*)A.kA + (size_t)t0_ * A.kA_pitch * 2; const char* kBb_ = (const char*)A.kB + (size_t)t0_ * A.kB_pitch * 2; const char* vb_ = (const char*)A.v + (size_t)t0_ * A.v_pitch * 2; \
        _Pragma("unroll") for (int i = 0; i < KPT; ++i) { const char* b_ = (MODE == 0) ? (i < 2 ? kAb_ : kBb_) : ((MODE == 1 && i == 1) ? kBb_ : kAb_); \
            glds16(b_ + koff[i], (unsigned)__builtin_amdgcn_readfirstlane((int)(lds0 + (unsigned)((slotoff) + i * 8192 + w * 1024)))); } \
        _Pragma("unroll") for (int i = 0; i < VPT; ++i) \
            glds16(vb_ + voff[i], (unsigned)__builtin_amdgcn_readfirstlane((int)(lds0 + (unsigned)((slotoff) + KBYTES + (w + 8 * i) * 1024)))); } while (0)
#define WAITV(n) asm volatile("s_waitcnt vmcnt(" #n ")" ::: "memory")
#define WAIT_TILE(more) do { if (more) { if (PT == 2) WAITV(2); else if (PT == 4) WAITV(4); else WAITV(5); } else WAITV(0); } while (0)
#define WAIT_TILE2(newer) do { if ((newer) >= 2) { if (PT == 2) WAITV(4); else if (PT == 4) WAITV(8); else WAITV(10); } else WAIT_TILE((newer) >= 1); } while (0)
#define BAR() do { __builtin_amdgcn_s_barrier(); asm volatile("" ::: "memory"); } while (0)
    const unsigned lds0 = (unsigned)(uintptr_t)lds;
    int s_cur = 0, s_n1 = STG, s_n2 = 2 * STG, s_n3 = 3 * STG;
    if (XS && pre) { WAITV(8);
#pragma unroll
        for (int s = 0; s < DQK / 16; ++s) asm volatile("" : "+v"(qf[s]));
    } else {
    DMA_TILE(0, 0);
    if (A.nt > 1) DMA_TILE(1, STG);
    if (DIST > 2 && A.nt > 2) DMA_TILE(2, 2 * STG);
#pragma unroll
    for (int s = 0; s < DQK / 16; ++s) qf[s] = *(const bf16x8*)(qrow + 16 * s + 8 * hi);
    WAITV(0);
#pragma unroll
    for (int s = 0; s < DQK / 16; ++s) asm volatile("" : "+v"(qf[s]));
    }
#pragma unroll
    for (int s = 0; s < DQK / 16; ++s) asm volatile("" : "+v"(qf[s]));
    if (MODE == 0) {
        float ss = 0.f;
#pragma unroll
        for (int s = 0; s < DQK / 16; ++s) { float v[8]; unpack8(__builtin_bit_cast(u32x4, qf[s]), v);
#pragma unroll
            for (int j = 0; j < 8; ++j) ss += v[j] * v[j]; }
        ss = pg8::sum_xor32(ss);
        const float rn = QS_MLA / sqrtf(ss * (1.0f / 192.0f) + EPS);
        const int tq = A.qt0 + qrow_idx; const bool lat = tq >= CTXL; const int tl = lat ? tq - CTXL : 0;
#pragma unroll
        for (int s = 0; s < 8; ++s) { float v[8]; unpack8(__builtin_bit_cast(u32x4, qf[s]), v);
            const f32x4 g0 = *(const f32x4*)(A.qg + 16 * s + 8 * hi), g1 = *(const f32x4*)(A.qg + 16 * s + 8 * hi + 4);
            v[0] *= rn * g0[0]; v[1] *= rn * g0[1]; v[2] *= rn * g0[2]; v[3] *= rn * g0[3]; v[4] *= rn * g1[0]; v[5] *= rn * g1[1]; v[6] *= rn * g1[2]; v[7] *= rn * g1[3];
            qf[s] = __builtin_bit_cast(bf16x8, pack8(v)); asm volatile("" : "+v"(qf[s])); }
#pragma unroll
        for (int h2 = 0; h2 < 2; ++h2) {
            float x1[8], x2[8]; unpack8(__builtin_bit_cast(u32x4, qf[8 + 2 * h2]), x1); unpack8(__builtin_bit_cast(u32x4, qf[9 + 2 * h2]), x2);
            const float* ga = A.qg + 16 * (8 + 2 * h2) + 8 * hi; const float* gb = ga + 16;
            const float* rt = A.ropet + (((h2 == 0) ? (tl >> 6) : (tl & 63)) * 16 + 8 * hi) * 2;
#pragma unroll
            for (int j = 0; j < 8; ++j) { const float a1 = x1[j] * rn * ga[j], a2 = x2[j] * rn * gb[j]; const float cs = lat ? rt[2 * j] : 1.0f, sn = lat ? rt[2 * j + 1] : 0.0f;
                x1[j] = a1 * cs - a2 * sn; x2[j] = a1 * sn + a2 * cs; }
            qf[8 + 2 * h2] = __builtin_bit_cast(bf16x8, pack8(x1)); qf[9 + 2 * h2] = __builtin_bit_cast(bf16x8, pack8(x2));
            asm volatile("" : "+v"(qf[8 + 2 * h2]), "+v"(qf[9 + 2 * h2])); }
    }
    if (grp == 1) { WAIT_TILE(A.nt > 1); BAR(); }
    const int vlane = ((lane >> 4) & 1) * 32 + (lane & 3) * 8 + (4 * hi + ((lane & 15) >> 2)) * 64;
    int kx[4];
#pragma unroll
    for (int q = 0; q < 4; ++q) kx[q] = r32 * 128 + (((2 * q + hi) ^ ((r32 >> 1) & 7)) << 4);
#pragma nounroll
    for (int t = 0; t < A.nt; ++t) {
        if (grp == 0) { if (DIST == 3) WAIT_TILE2(A.nt - 1 - t); else WAIT_TILE(t + 1 < A.nt); }
        BAR();
        if (MODE == 2) { if (t + DIST < A.nt) DMA_TILE(t + DIST, s_n3); } else if (grp == 1 && t + 2 < A.nt) DMA_TILE(t + 2, s_n2);
        bool active = true; int kr = 0; const bool namask = (MODE == 2) && (t >= 4);
        if (MODE == 2 && t >= 4) { kr = A.klo + t - 4; active = (kr >= rs_w) && (kr <= rs_w + 7); }
        if (ABL == 1) active = false;
        const LAS unsigned char* kb = lds + s_cur + (MODE == 1 ? comp * 8192 : 0);
        const LAS unsigned char* vb = lds + s_cur + KBYTES + vlane;
        f32x16 p0 = (f32x16){0.f, 0.f, 0.f, 0.f, 0.f, 0.f, 0.f, 0.f, 0.f, 0.f, 0.f, 0.f, 0.f, 0.f, 0.f, 0.f}, p1 = p0;
        if (MODE == 2) {
            const LAS float* bl = rpbl + ((t >= 4) ? (kr - rq + 7) : 15) * 128 + (4 * hi - cq + 63);
#pragma unroll
            for (int r = 0; r < 16; ++r) { p0[r] = bl[(r & 3) + 8 * (r >> 2)]; p1[r] = bl[32 + (r & 3) + 8 * (r >> 2)]; }
        }
        bf16x8 pf[4];
        v4i16_t va[8], vb2[8];
#define SB() __builtin_amdgcn_sched_barrier(0)
#define KFRAG(s_, half_) (*(const LAS bf16x8*)(kb + ((s_) >> 2) * 8192 + kx[(s_) & 3] + (half_) * 4096))
#define KREAD(dst, b) do { dst[0] = KFRAG(2 * (b), 0); dst[1] = KFRAG(2 * (b), 1); dst[2] = KFRAG(2 * (b) + 1, 0); dst[3] = KFRAG(2 * (b) + 1, 1); } while (0)
#define KMMA(src, b) do { p0 = __builtin_amdgcn_mfma_f32_32x32x16_bf16(src[0], qf[2 * (b)], p0, 0, 0, 0); p1 = __builtin_amdgcn_mfma_f32_32x32x16_bf16(src[1], qf[2 * (b)], p1, 0, 0, 0); \
                          p0 = __builtin_amdgcn_mfma_f32_32x32x16_bf16(src[2], qf[2 * (b) + 1], p0, 0, 0, 0); p1 = __builtin_amdgcn_mfma_f32_32x32x16_bf16(src[3], qf[2 * (b) + 1], p1, 0, 0, 0); } while (0)
#define VREAD(dst, d) do { _Pragma("unroll") for (int ks_ = 0; ks_ < 4; ++ks_) { dst[2 * ks_] = __builtin_amdgcn_ds_read_tr16_b64_v4i16((LAS v4i16_t*)(vb + (d) * 4096 + ks_ * 1024)); \
                                                                             dst[2 * ks_ + 1] = __builtin_amdgcn_ds_read_tr16_b64_v4i16((LAS v4i16_t*)(vb + (d) * 4096 + ks_ * 1024 + 512)); } } while (0)
#define VMMA(src, d) do { _Pragma("unroll") for (int ks_ = 0; ks_ < 4; ++ks_) { const bf16x8 vf_ = (bf16x8){src[2 * ks_][0], src[2 * ks_][1], src[2 * ks_][2], src[2 * ks_][3], src[2 * ks_ + 1][0], src[2 * ks_ + 1][1], src[2 * ks_ + 1][2], src[2 * ks_ + 1][3]}; \
                              o[d] = __builtin_amdgcn_mfma_f32_32x32x16_bf16(vf_, pf[ks_], o[d], 0, 0, 0); } } while (0)
        if (active) {
            bf16x8 fa[4], fb[4];
            constexpr int NB = DQK / 32;
            KREAD(fa, 0);
#pragma unroll
            for (int b = 0; b < NB; b += 2) {
                KREAD(fb, b + 1); SB(); KMMA(fa, b); SB();
                if (b + 2 < NB) KREAD(fa, b + 2);
                SB(); KMMA(fb, b + 1); SB();
            }
            if (ABL == 3) { asm volatile("" :: "v"(p0), "v"(p1)); } else {
            SB();
            float rsum = 0.f;
#define EXPPACK(ks_, P, base) do { float e_[8]; _Pragma("unroll") for (int j_ = 0; j_ < 8; ++j_) { e_[j_] = __builtin_amdgcn_exp2f(P[(base) + j_]); \
                    if (MODE == 2 && namask) e_[j_] = __uint_as_float(__float_as_uint(e_[j_]) & (unsigned)__builtin_amdgcn_sbfe((int)((ks_) < 2 ? vm0 : vm1), (base) + j_, 1)); } \
                rsum += ((e_[0] + e_[1]) + (e_[2] + e_[3])) + ((e_[4] + e_[5]) + (e_[6] + e_[7])); pf[ks_] = pack8f(e_[0], e_[1], e_[2], e_[3], e_[4], e_[5], e_[6], e_[7]); SB(); } while (0)
            EXPPACK(0, p0, 0); EXPPACK(1, p0, 8); EXPPACK(2, p1, 0); EXPPACK(3, p1, 8);
#undef EXPPACK
            lsum += rsum;
            }
        }
        if (grp == 1 && t + 1 < A.nt) WAIT_TILE(t + 2 < A.nt);
        if (MODE != 2) BAR();
        if (MODE != 2 && grp == 0 && t + 2 < A.nt) DMA_TILE(t + 2, s_n2);
        if (active && ABL != 3) {
            if (ABL == 2) { asm volatile("" :: "v"(pf[0]), "v"(pf[1]), "v"(pf[2]), "v"(pf[3])); } else {
            constexpr int ND = DV / 32;
            VREAD(va, 0);
#pragma unroll
            for (int d = 0; d < ND; d += 2) {
                VREAD(vb2, d + 1); SB(); VMMA(va, d); SB();
                if (d + 2 < ND) VREAD(va, d + 2);
                SB(); VMMA(vb2, d + 1); SB();
            }
            }
        }
#undef SB
#undef KFRAG
#undef KREAD
#undef KMMA
#undef VREAD
#undef VMMA
        if (NSLOT == 4) { const int tmp = s_cur; s_cur = s_n1; s_n1 = s_n2; s_n2 = s_n3; s_n3 = tmp; } else { const int tmp = s_cur; s_cur = s_n1; s_n1 = s_n2; s_n2 = tmp; }
    }
    if (MODE != 2 && grp == 0) BAR();
    BAR();
    if (XS && has_next) {
        DMA_TILE(0, 0); DMA_TILE(1, STG); DMA_TILE(2, 2 * STG);
        const bf16_t* qn = qrow + (size_t)256 * A.q_pitch;
#pragma unroll
        for (int s = 0; s < DQK / 16; ++s) qf[s] = *(const bf16x8*)(qn + 16 * s + 8 * hi);
    }
    const float l = pg8::sum_xor32(lsum);
    linv = 1.0f / l;
#undef TILE_T0
#undef DMA_TILE
#undef WAITV
#undef WAIT_TILE
#undef WAIT_TILE2
#undef BAR
}

template <int NDV>
__device__ __forceinline__ void store_o(const f32x16 (&o)[NDV], float sc, bf16_t* orow, int hi) {
#pragma unroll
    for (int d = 0; d < NDV; ++d)
#pragma unroll
        for (int g = 0; g < 4; ++g) { u32x2 wv; wv.x = cvtpk(o[d][4 * g] * sc, o[d][4 * g + 1] * sc); wv.y = cvtpk(o[d][4 * g + 2] * sc, o[d][4 * g + 3] * sc);
            *(u32x2*)(orow + 32 * d + 8 * g + 4 * hi) = wv; }
}

constexpr int DA_XBUF = 0;
constexpr int NA_RPB = 4 * (8192 + 8192);

template <int ABL = 0>
__device__ __forceinline__ void mla_unit(Frame& F, const Params& p, int b, int h, int qb) {
    const bf16_t* PROJ = (const bf16_t*)(F.ws + WS_REG); const bf16_t* QRAW = (const bf16_t*)(F.ws + WS_QRAW); const bf16_t* KVRAW = (const bf16_t*)(F.ws + WS_KVRAW);
    bf16_t* Y = (bf16_t*)(F.ws + WS_Y);
    const size_t R0 = (size_t)b * TU;
    AttnArgs A; A.q = QRAW + (R0 + 256 * qb) * 768 + 192 * h; A.q_pitch = 768;
    A.kA = KVRAW + R0 * 1024 + 256 * h; A.kA_pitch = 1024; A.kB = PROJ + R0 * 2048 + 1920; A.kB_pitch = 2048;
    A.v = KVRAW + R0 * 1024 + 256 * h + 128; A.v_pitch = 1024; A.nt = (qb == 0) ? 4 : 36; A.klo = 0; A.r0 = 0; A.qg = INP(IN_MQG); A.ropet = (const float*)(F.ws + WS_SMALL); A.qt0 = 256 * qb;
    f32x16 o[4]; float linv; bf16x8 qf[12];
    attn_core<0, ABL>(F.lds, A, o, linv, nullptr, qf);
    int lane_ = F.lane; asm volatile("" : "+v"(lane_));
    const int r32 = lane_ & 31, hi = lane_ >> 5;
    store_o<4>(o, linv, Y + (R0 + 256 * qb + 32 * F.wave + r32) * 1024 + 512 + 128 * h, hi);
}
template <int ABL = 0>
__device__ __forceinline__ void da_unit(Frame& F, const Params& p, int b, int h, int qb, float lam) {
    const bf16_t* PROJ = (const bf16_t*)(F.ws + WS_REG); bf16_t* Y = (bf16_t*)(F.ws + WS_Y);
    const size_t R0 = (size_t)b * TU;
    AttnArgs A; A.q = PROJ + (R0 + 128 * qb) * 2048 + 128 * h; A.q_pitch = 2048;
    A.kA = PROJ + R0 * 2048 + 512 + 128 * h; A.kA_pitch = 2048; A.kB = A.kA + 64; A.kB_pitch = 2048;
    A.v = PROJ + R0 * 2048 + 1024 + 128 * h; A.v_pitch = 2048; A.nt = (qb < 2) ? 4 : 36; A.klo = 0; A.r0 = 0; A.qg = nullptr; A.ropet = nullptr; A.qt0 = 0;
    f32x16 o[4]; float linv; bf16x8 qf[4];
    attn_core<1, ABL>(F.lds, A, o, linv, nullptr, qf);
    int lane_ = F.lane; asm volatile("" : "+v"(lane_));
    const int r32 = lane_ & 31, hi = lane_ >> 5, comp = F.wave >> 2;
    LAS float* xb = (LAS float*)(F.lds + DA_XBUF) + (F.wave & 3) * 4096;
    if (comp == 1) {
#pragma unroll
        for (int d = 0; d < 4; ++d)
#pragma unroll
            for (int r = 0; r < 16; ++r) xb[(d * 16 + r) * 64 + lane_] = o[d][r] * linv; }
    __syncthreads();
    if (comp == 0) {
        float ss = 0.f;
#pragma unroll
        for (int d = 0; d < 4; ++d) {
#pragma unroll
            for (int r = 0; r < 16; ++r) { const float v = o[d][r] * linv - lam * xb[(d * 16 + r) * 64 + lane_]; o[d][r] = v; ss += v * v; }
            __builtin_amdgcn_sched_barrier(0); }
        ss += __shfl_xor(ss, 32);
        const float sc = (1.0f - LAM_INIT0) / sqrtf(ss * (1.0f / 128.0f) + EPS);
        const float* og = INP(IN_DAOG);
#pragma unroll
        for (int d = 0; d < 4; ++d)
#pragma unroll
            for (int g = 0; g < 4; ++g) { const f32x4 gv = *(const f32x4*)(og + 32 * d + 8 * g + 4 * hi);
                o[d][4 * g] *= gv.x; o[d][4 * g + 1] *= gv.y; o[d][4 * g + 2] *= gv.z; o[d][4 * g + 3] *= gv.w; }
        store_o<4>(o, sc, Y + (R0 + 128 * qb + 32 * (F.wave & 3) + r32) * 1024 + 128 * h, hi);
    }
    __syncthreads();
}
template <int ABL = 0>
__device__ __forceinline__ void na_unit(Frame& F, const Params& p, int b, int h, int band, bf16x8 (&qf)[4]) {
    const bf16_t* P1 = (const bf16_t*)(F.ws + WS_REG); bf16_t* Y = (bf16_t*)(F.ws + WS_Y);
    const size_t R0 = (size_t)b * TU;
    const int r0 = 4 * band; const int klo = r0 - 4 < 0 ? 0 : (r0 - 4 > 24 ? 24 : r0 - 4); const int rs3 = r0 - 1 < 0 ? 0 : (r0 - 1 > 24 ? 24 : r0 - 1); const int khi = rs3 + 7;
    AttnArgs A; A.q = P1 + (R0 + CTXL + 64 * r0) * ODN + 64 * h; A.q_pitch = ODN;
    A.kA = P1 + R0 * ODN + 1024 + 64 * h; A.kA_pitch = ODN; A.kB = A.kA; A.kB_pitch = ODN;
    A.v = P1 + R0 * ODN + 2048 + 64 * h; A.v_pitch = ODN; A.nt = 4 + (khi - klo + 1); A.klo = klo; A.r0 = r0; A.qg = nullptr; A.ropet = nullptr; A.qt0 = 0;
    f32x16 o[2]; float linv;
    attn_core<2, ABL, true>(F.lds, A, o, linv, (const LAS float*)(F.lds + NA_RPB), qf, band > 0, band < 7);
    int lane_ = F.lane; asm volatile("" : "+v"(lane_));
    const int r32 = lane_ & 31, hi = lane_ >> 5;
    store_o<2>(o, linv, Y + (R0 + CTXL + 64 * (r0 + (F.wave >> 1)) + 32 * (F.wave & 1) + r32) * 1024 + 64 * h, hi);
}


#define RLX_AGENT __ATOMIC_RELAXED, __HIP_MEMORY_SCOPE_AGENT
#define XB_TMO      128
#define XB_XCNT(j)  (256  + 64 * (j))
#define XB_XSUB(j)  (1280 + 64 * (j))
#define XB_XGEN(j)  (2304 + 64 * (j))
#define XB_TOP      3328
#define XB_TOPGEN   3392
#define XCD_BAR_WORDS 3456
#define XB_SPIN_CAP (1u << 18)

__device__ __forceinline__ unsigned xb_ld(unsigned* p)              { return __hip_atomic_load(p, __ATOMIC_RELAXED, __HIP_MEMORY_SCOPE_AGENT); }
__device__ __forceinline__ unsigned xb_add(unsigned* p, unsigned v) { return __hip_atomic_fetch_add(p, v, __ATOMIC_RELAXED, __HIP_MEMORY_SCOPE_AGENT); }
__device__ __forceinline__ unsigned xb_xcc_id() { return (unsigned)__builtin_amdgcn_s_getreg((3 << 11) | 20) & 0xFu; }
#define XB_SPIN(cond, bar) do { unsigned _sp = 0; while (cond) { __builtin_amdgcn_s_sleep(1); \
    if ((++_sp & 255u) == 0u) { if (xb_ld(&(bar)[XB_TMO])) break; if (_sp > XB_SPIN_CAP) { atomicAdd(&(bar)[XB_TMO], 1u); break; } } } } while (0)

struct XcdBarrier {
    unsigned* bar; unsigned x;
    volatile LAS unsigned* st;
};

__device__ __forceinline__ XcdBarrier xcd_barrier_post(unsigned* bar, volatile LAS unsigned* st) {
    XcdBarrier b; b.bar = bar; b.x = xb_xcc_id(); b.st = st;
    if (threadIdx.x == 0) (void)xb_add(&bar[XB_XCNT(b.x)], 1u);
    return b;
}
__device__ __forceinline__ void xcd_barrier_complete(unsigned* bar, unsigned x, unsigned& nloc, unsigned& nx) {
    const unsigned G = gridDim.x * gridDim.y * gridDim.z;
    unsigned sum, cnt, mine, sp = 0u;
    for (;;) {
        sum = 0u; cnt = 0u; mine = 0u;
#pragma unroll
        for (unsigned j = 0; j < 16; ++j) { const unsigned c = xb_ld(&bar[XB_XCNT(j)]); sum += c; cnt += (c > 0u) ? 1u : 0u; mine = (j == x) ? c : mine; }
        if (sum == G) break;
        __builtin_amdgcn_s_sleep(1);
        if ((++sp & 255u) == 0u) { if (xb_ld(&bar[XB_TMO])) break; if (sp > XB_SPIN_CAP) { atomicAdd(&bar[XB_TMO], 1u); break; } }
    }
    nloc = mine > 0u ? mine : 1u; nx = cnt > 0u ? cnt : 1u;
}

__device__ __forceinline__ void xcd_barrier(const XcdBarrier& b) {
    asm volatile("s_waitcnt vmcnt(0)" ::: "memory");
    __syncthreads();
    if (threadIdx.x == 0) {
        unsigned* bar = b.bar;
        __builtin_amdgcn_s_waitcnt(0);
        unsigned nloc = b.st[0], nx = b.st[1];
        if (nloc == 0u) { xcd_barrier_complete(bar, b.x, nloc, nx); b.st[0] = nloc; b.st[1] = nx; }
        const unsigned old = xb_add(&bar[XB_XSUB(b.x)], 1u);
        const unsigned gen = old / nloc;
        if (old + 1u == (gen + 1u) * nloc) {
            __builtin_amdgcn_fence(__ATOMIC_RELEASE, "agent");
            asm volatile("s_waitcnt vmcnt(0)" ::: "memory");
            const unsigned og = xb_add(&bar[XB_TOP], 1u);
            const unsigned tg = og / nx;
            if (og + 1u == (tg + 1u) * nx) xb_add(&bar[XB_TOPGEN], 1u);
            else XB_SPIN(xb_ld(&bar[XB_TOPGEN]) == tg, bar);
            __builtin_amdgcn_fence(__ATOMIC_ACQUIRE, "agent");
            xb_add(&bar[XB_XGEN(b.x)], 1u);
            asm volatile("s_waitcnt vmcnt(0)" ::: "memory");
        } else {
            XB_SPIN(xb_ld(&bar[XB_XGEN(b.x)]) == gen, bar);
            __builtin_amdgcn_fence(__ATOMIC_ACQUIRE, "agent");
            asm volatile("s_waitcnt vmcnt(0)" ::: "memory");
        }
    }
    __syncthreads();
}

__device__ __forceinline__ void zero_state(Frame& F) {
    if (F.bid == 0) { unsigned* bar = (unsigned*)(F.ws + WS_CTL) + 4096; for (int i = F.tid; i < XCD_BAR_WORDS; i += 512) __hip_atomic_store(bar + i, 0u, __ATOMIC_RELAXED, __HIP_MEMORY_SCOPE_AGENT); }
    const pg8::u32x4 z = {0u, 0u, 0u, 0u};
    for (int e = F.bid * 512 + F.tid; e < 1024 * 16; e += F.G * 512) { const int row = e >> 4, c = e & 15; *(pg8::u32x4*)(F.ws + WS_WUKV + (size_t)row * 512 + 256 + c * 16) = z; }
    for (int e = F.bid * 512 + F.tid; e < 64 * 128; e += F.G * 512) { const int rr = e >> 7, c = e & 127; const int row = (rr < 32 ? 1888 : 1984) + rr; *(pg8::u32x4*)(F.ws + WS_WEV + (size_t)row * 2048 + c * 16) = z; }
}

constexpr int N_PHASES = 15;
__global__ void __launch_bounds__(512, 2) fwd_kernel(Params p) {
    extern __shared__ __attribute__((aligned(16))) unsigned char lds_raw[];
    Frame F;
    F.lds = (LAS unsigned char*)lds_raw;
    F.tid = threadIdx.x; F.lane = F.tid & 63; F.wave = __builtin_amdgcn_readfirstlane(F.tid >> 6); F.G = gridDim.x; F.bid = blockIdx.x;
    F.out = p.out; F.ws = p.ws; F.abl = p.abl;
    cg::grid_group grid = cg::this_grid();
    const int lo = p.ph_lo, hi_ = p.ph_hi;
    volatile LAS unsigned* xbst = (volatile LAS unsigned*)(F.lds + LDS_BYTES - 64);
    if (F.tid < 2) xbst[F.tid] = 0u;
    __syncthreads();
    XcdBarrier xbar; xbar.bar = (unsigned*)(F.ws + WS_CTL) + 4096; xbar.x = xb_xcc_id(); xbar.st = xbst;
    if (lo > 0 && F.tid == 0) (void)xb_add(&xbar.bar[XB_XCNT(xbar.x)], 1u);
#ifndef PH_MASK
#define PH_MASK 0x7fff
#endif
#define PH(k) (((PH_MASK >> (k)) & 1) && lo <= (k) && (k) < hi_)
#ifndef USE_XB
#define USE_XB 1
#endif
#define SEAM(k) do { if (PH(k) && PH((k) + 1)) { if (!USE_XB || (k) == 0) grid.sync(); else xcd_barrier(xbar); } } while (0)
    bf16_t* const XN = (bf16_t*)(F.ws + WS_XN); bf16_t* const Y = (bf16_t*)(F.ws + WS_Y);
    bf16_t* const REG = (bf16_t*)(F.ws + WS_REG);
    bf16_t* const XR16 = (bf16_t*)(F.ws + WS_XR16);
    const float* const modv = (const float*)(F.ws + WS_MODV);
    using pg8::Gemm; using pg8::StaticOrder; using pg8::LatentOrder; using pg8::EpiStore; using pg8::EpiRes; using pg8::EpiSwiGLU;

    const float* const ropet = (const float*)(F.ws + WS_SMALL);
#define SSQP(slot, k) ((float*)(F.ws + WS_SSQ + (size_t)((F.abl && (k) == hi_ - 1) ? 5 : (slot)) * SSQ_STRIDE))
    if (PH(0)) { p0_prologue(F, p); zero_state(F); }
    SEAM(0);
    if (lo == 0 && F.tid == 0) (void)xb_add(&xbar.bar[XB_XCNT(xbar.x)], 1u);
    if (PH(1)) { norm_pass(F, p, 0, INP(IN_NMIX), 0, 1, true, false); shw_pass(F); }
    SEAM(1);
    if (PH(2)) { Gemm g{XN, (const bf16_t*)(F.ws + WS_WEV), MROWS, EVNP, 1024, 1024}; StaticOrder S; S.init(MROWS, EVNP, F.G, F.bid);
        const float* gq = INP(IN_DAQG); const float* gk = INP(IN_DAKG); const float* gr = INP(IN_MKRG); float* const sq_cq = SSQP(0, 2); float* const sq_ckv = SSQP(1, 2);
        auto gf = [=](int g) -> pg8::ProjGroup { if (g < 8) return {1, gq, QS_DA, 1, nullptr}; if (g < 16) return {1, gk, 1.0f, 1, nullptr}; if (g < 24) return {0, nullptr, 1.0f, 0, nullptr};
            if (g < 28) return {2, nullptr, 1.0f, 0, sq_cq}; if (g < 30) return {2, nullptr, 1.0f, 0, sq_ckv}; if (g == 30) return {1, gr, 1.0f, 1, nullptr}; return {0, nullptr, 1.0f, 0, nullptr}; };
        pg8::EpiProj<false, decltype(gf)> E{REG, 2048, nullptr, nullptr, 0, ropet, gf};
        pg8::gemm_phase<pg8::EpiProj<false, decltype(gf)>, StaticOrder, true, true>(F.lds, g, S, E); }
    SEAM(2);
    if (PH(3)) {
        int kup = 256; asm volatile("" : "+s"(kup));
        Gemm g{REG, (const bf16_t*)(F.ws + WS_WUQ), MROWS, 1792, kup, 2048}; pg8::UpOrder S; S.init(MROWS, 1792, F.G, F.bid);
        pg8::EpiUp E{(bf16_t*)(F.ws + WS_QRAW), (bf16_t*)(F.ws + WS_KVRAW), (const float*)(F.ws + WS_SSQ), (const float*)(F.ws + WS_SSQ + SSQ_STRIDE)};
        pg8::gemm_phase<pg8::EpiUp, pg8::UpOrder, true, true>(F.lds, g, S, E);
    }
    SEAM(3);
    if (PH(4)) post_up0(F, p);
    SEAM(4);
    if (PH(5)) {
        float lam; { const float a = INP(IN_LQ1)[F.lane] * INP(IN_LK1)[F.lane], b2 = INP(IN_LQ2)[F.lane] * INP(IN_LK2)[F.lane]; lam = __expf(wave_sum(a)) - __expf(wave_sum(b2)) + LAM_INIT0; }
        const int xcd = F.bid & 7, slot = F.bid >> 3;
        if (F.G == 256) {
            for (int i = 0; i < 2; ++i) { const int g = xcd * 8 + 4 * i + (slot >> 3), qb = 1 + (slot & 7); mla_unit<0>(F, p, g >> 2, g & 3, qb); }
            for (int i = 0; i < 4; ++i) { const int g = xcd * 8 + 2 * i + (slot >> 4), qb = 2 + (slot & 15); da_unit<0>(F, p, g >> 2, g & 3, qb, lam); }
            if (F.bid < 128) { const int g = F.bid >> 1; da_unit<0>(F, p, g >> 2, g & 3, F.bid & 1, lam); }
            else if (F.bid < 192) { const int g = F.bid - 128; mla_unit<0>(F, p, g >> 2, g & 3, 0); }
        } else {
            for (int u = F.bid; u < 64 * 9; u += F.G) { const int g = u / 9, qb = u % 9; mla_unit<0>(F, p, g >> 2, g & 3, qb); }
            for (int u = F.bid; u < 64 * 18; u += F.G) { const int g = u / 18, qb = u % 18; da_unit<0>(F, p, g >> 2, g & 3, qb, lam); }
        }
    }
    SEAM(5);
    const int slot32 = F.bid >> 3, pos_of = slot32 >= 8 ? slot32 - 8 : 24 + slot32;
    if (PH(6)) { Gemm g{Y, (const bf16_t*)(F.ws + WS_WO), MROWS, 1024, 1024, 1024}; LatentOrder S; S.init(1024, F.G, F.bid);
        pg8::EpiRes3<true, false> E{INP(IN_X), INP(IN_CTX), XR16, F.out, modv, 2, XN, SSQP(2, 6), INP(IN_NFFN), modv, 4};
        pg8::gemm_phase<pg8::EpiRes3<true, false>, LatentOrder, true, true>(F.lds, g, S, E); }
    SEAM(6);
    if (PH(7)) {
        { Gemm g{Y, (const bf16_t*)(F.ws + WS_WO), MROWS, 1024, 1024, 1024}; pg8::XcdOrder S; S.init(F.bid, 1, 4, 0, slot32, 1, 8, 0, 8, 0);
          pg8::EpiRes3<true, false> E{INP(IN_X), INP(IN_CTX), XR16, F.out, modv, 2, XN, SSQP(2, 7), INP(IN_NFFN), modv, 4};
          pg8::gemm_phase<pg8::EpiRes3<true, false>, pg8::XcdOrder, true, true>(F.lds, g, S, E); }
        { Gemm g{XN, (const bf16_t*)(F.ws + WS_WFI), MROWS, 2 * DFF, 1024, 1024}; pg8::XcdOrder S; S.init(F.bid, 0, 22, 0, pos_of, 12, 8, 11, 24, 10);
          pg8::EpiSwiGLU2 E{REG, (const float*)(F.ws + WS_SSQ + 2 * SSQ_STRIDE), (const float*)(F.ws + WS_SHW + SHW_F0)};
          pg8::gemm_phase<pg8::EpiSwiGLU2, pg8::XcdOrder, true, true>(F.lds, g, S, E); }
    }
    SEAM(7);
    if (PH(8)) {
        { Gemm g{REG, (const bf16_t*)(F.ws + WS_WFO), MROWS, 1024, DFF, HIDP}; pg8::XcdOrder S; S.init(F.bid, 0, 4, 0, slot32, 2, 32, 2, 32, 2);
          pg8::EpiRes3<false, false> E{nullptr, nullptr, XR16, F.out, modv, 5, XN, SSQP(3, 8), INP(IN_NMIX) + 1024, modv + 17 * 6144, 1};
          pg8::gemm_phase<pg8::EpiRes3<false, false>, pg8::XcdOrder, true, true>(F.lds, g, S, E); }
        { Gemm g{XN, (const bf16_t*)(F.ws + WS_WFI), MROWS, 2 * DFF, 1024, 1024}; pg8::XcdOrder S; S.init(F.bid, 1, 22, 0, slot32, 2, 12, 1, 32, 1);
          pg8::EpiSwiGLU2 E{REG, (const float*)(F.ws + WS_SSQ + 2 * SSQ_STRIDE), (const float*)(F.ws + WS_SHW + SHW_F0)};
          pg8::gemm_phase<pg8::EpiSwiGLU2, pg8::XcdOrder, true, true>(F.lds, g, S, E); }
    }
    SEAM(8);
    if (PH(9)) {
        { Gemm g{REG, (const bf16_t*)(F.ws + WS_WFO), MROWS, 1024, DFF, HIDP}; pg8::XcdOrder S; S.init(F.bid, 1, 4, 0, slot32, 1, 8, 0, 8, 0);
          pg8::EpiRes3<false, false> E{nullptr, nullptr, XR16, F.out, modv, 5, XN, SSQP(3, 9), INP(IN_NMIX) + 1024, modv + 17 * 6144, 1};
          pg8::gemm_phase<pg8::EpiRes3<false, false>, pg8::XcdOrder, true, true>(F.lds, g, S, E); }
        { Gemm g{XN, (const bf16_t*)(F.ws + WS_WOD), MROWS, ODN, 1024, 1024}; pg8::XcdOrder S; S.init(F.bid, 0, 12, 0, pos_of, 7, 16, 6, 24, 4);
          const float* gq1 = INP(IN_NAQG); const float* gk1 = INP(IN_NAKG);
          auto gf_od = [=](int g) -> pg8::ProjGroup { if (g < 16) return {1, gq1, QS_NA, 0, nullptr}; if (g < 32) return {1, gk1, 1.0f, 0, nullptr}; return {0, nullptr, 1.0f, 0, nullptr}; };
          typedef pg8::EpiProj<true, decltype(gf_od)> EpiOd;
          EpiOd E{REG, ODN, (const float*)(F.ws + WS_SSQ + 3 * SSQ_STRIDE), (const float*)(F.ws + WS_SHW + SHW_OD), 3072, ropet, gf_od};
          pg8::gemm_phase<EpiOd, pg8::XcdOrder, true, true>(F.lds, g, S, E); }
    }
    SEAM(9);
    if (PH(10)) { Gemm g{XN, (const bf16_t*)(F.ws + WS_WOD), MROWS, ODN, 1024, 1024}; pg8::XcdOrder S; S.init(F.bid, 1, 8, 4, slot32, 1, 16, 0, 16, 0);
        const float* gq1 = INP(IN_NAQG); const float* gk1 = INP(IN_NAKG);
          auto gf_od = [=](int g) -> pg8::ProjGroup { if (g < 16) return {1, gq1, QS_NA, 0, nullptr}; if (g < 32) return {1, gk1, 1.0f, 0, nullptr}; return {0, nullptr, 1.0f, 0, nullptr}; };
          typedef pg8::EpiProj<true, decltype(gf_od)> EpiOd;
          EpiOd E{REG, ODN, (const float*)(F.ws + WS_SSQ + 3 * SSQ_STRIDE), (const float*)(F.ws + WS_SHW + SHW_OD), 3072, ropet, gf_od};
        pg8::gemm_phase<EpiOd, pg8::XcdOrder, true, true>(F.lds, g, S, E); }
    SEAM(10);
    if (PH(11)) {
        for (int pr = F.bid; pr < 256; pr += F.G) { const int b = pr >> 4, h = pr & 15;
            LAS float* rp = (LAS float*)(F.lds + NA_RPB);
            __syncthreads();
            for (int i = F.tid; i < 16 * 128; i += 512) { const int dr = i >> 7, jx = (i & 127) - 48; rp[i] = (dr < 15 && jx >= 0 && jx < 31) ? INP(IN_RPB)[h * 465 + dr * 31 + jx] * LOG2E : 0.f; }
            bf16x8 qf[4];
#pragma nounroll
            for (int band = 0; band < 8; ++band) na_unit<0>(F, p, b, h, band, qf); }
    }
    SEAM(11);
    if (PH(12)) { Gemm g{Y, (const bf16_t*)(F.ws + WS_WO) + 1024 * 1024, MROWS, 1024, 1024, 1024}; LatentOrder S; S.init(1024, F.G, F.bid);
        pg8::EpiRes3<false, false> E{nullptr, nullptr, XR16, F.out, modv + 17 * 6144, 2, XN, SSQP(4, 12), INP(IN_NFFN) + 1024, modv + 17 * 6144, 4};
        pg8::gemm_phase<pg8::EpiRes3<false, false>, LatentOrder, true, true>(F.lds, g, S, E); }
    SEAM(12);
    if (PH(13)) { Gemm g{XN, (const bf16_t*)(F.ws + WS_WFI) + (size_t)5632 * 1024, MROWS, 2 * DFF, 1024, 1024}; LatentOrder S; S.init(2 * DFF, F.G, F.bid);
        pg8::EpiSwiGLU2 E{REG, (const float*)(F.ws + WS_SSQ + 4 * SSQ_STRIDE), (const float*)(F.ws + WS_SHW + SHW_F1)};
        pg8::gemm_phase<pg8::EpiSwiGLU2, LatentOrder, true, true>(F.lds, g, S, E); }
    SEAM(13);
    if (PH(14)) { Gemm g{REG, (const bf16_t*)(F.ws + WS_WFO + 6 * MiB), MROWS, 1024, DFF, HIDP}; LatentOrder S; S.init(1024, F.G, F.bid);
        pg8::EpiRes3<false, true> E{nullptr, nullptr, XR16, F.out, modv + 17 * 6144, 5, nullptr, nullptr, nullptr, modv, 0};
        pg8::gemm_phase<pg8::EpiRes3<false, true>, LatentOrder, true, true>(F.lds, g, S, E); }
#undef PH
#undef SEAM
#undef SSQP
}

#ifndef PROBE_ABL
#define PROBE_ABL 0
#endif
#ifndef N_LAUNCHES
#define N_LAUNCHES 1
#endif
extern "C" void kernel_launch(void* const* d_in, const int* in_sizes, int n_in, void* d_out, int out_size, void* d_ws, size_t ws_size, hipStream_t stream) {
    static int grid = 0;
    if (grid == 0) {
        if (n_in != 30 || out_size != NBATCH * SEQ * DM || ws_size < WS_END) { fprintf(stderr, "kernel_launch: unexpected problem: n_in %d out %d ws %zu (need %zu)\n", n_in, out_size, ws_size, (size_t)WS_END); grid = -1; return; }
        int dev = 0, cus = 0, per_cu = 0;
        if (hipGetDevice(&dev) != hipSuccess || hipDeviceGetAttribute(&cus, hipDeviceAttributeMultiprocessorCount, dev) != hipSuccess) { grid = -1; return; }
        if (hipFuncSetAttribute((const void*)fwd_kernel, hipFuncAttributeMaxDynamicSharedMemorySize, LDS_BYTES) != hipSuccess) { fprintf(stderr, "kernel_launch: hipFuncSetAttribute failed\n"); grid = -1; return; }
        if (hipOccupancyMaxActiveBlocksPerMultiprocessor(&per_cu, (const void*)fwd_kernel, 512, LDS_BYTES) != hipSuccess || per_cu < 1) { fprintf(stderr, "kernel_launch: occupancy query says %d\n", per_cu); (void)hipGetLastError(); per_cu = 1; }
        grid = cus * (per_cu > 1 ? 1 : per_cu);
        fprintf(stderr, "kernel_launch: cus %d per_cu %d grid %d ws %zu MiB\n", cus, per_cu, grid, ws_size >> 20);
        if (grid != 256) { fprintf(stderr, "kernel_launch: this build's static schedules need exactly 256 workgroups (one per CU of a 256-CU device); nothing launched\n"); grid = -1; return; }
    }
    if (grid < 0) return;
    unsigned char* ws = (unsigned char*)d_ws;
#if defined(PROBE_K) || N_LAUNCHES != 1
    (void)hipMemsetAsync(ws + WS_CTL, 0, CTL_ZERO_BYTES, stream);
#endif
    Params p{};
    for (int i = 0; i < 30; ++i) p.in[i] = (const float*)d_in[i];
    p.out = (float*)d_out; p.ws = ws;
#if defined(PROBE_K)
    for (int li = 0; li < 2; ++li) { p.ph_lo = li == 0 ? 0 : PROBE_K; p.ph_hi = li == 0 ? PROBE_K + PROBE_REP : N_PHASES; p.abl = li == 0 ? PROBE_ABL : 0;
        if (li == 1) (void)hipMemsetAsync(ws + WS_CTL, 0, CTL_ZERO_BYTES, stream);
        void* args[] = {&p};
        hipError_t e = hipLaunchCooperativeKernel((void*)fwd_kernel, dim3(grid), dim3(512), args, LDS_BYTES, stream);
        if (e != hipSuccess) fprintf(stderr, "cooperative launch failed: %s (grid %d)\n", hipGetErrorString(e), grid); }
#elif N_LAUNCHES == 1
    p.ph_lo = 0; p.ph_hi = N_PHASES;
    void* args[] = {&p};
    hipError_t e = hipLaunchCooperativeKernel((void*)fwd_kernel, dim3(grid), dim3(512), args, LDS_BYTES, stream);
    if (e != hipSuccess) fprintf(stderr, "cooperative launch failed: %s (grid %d)\n", hipGetErrorString(e), grid);
#else
    for (int k = 0; k < N_PHASES; ++k) { p.ph_lo = k; p.ph_hi = k + 1; hipLaunchKernelGGL(fwd_kernel, dim3(grid), dim3(512), LDS_BYTES, stream, p); }
#endif
}
```

```cpp
#include <hip/hip_runtime.h>
#include <hip/hip_cooperative_groups.h>
#include <cstdio>
#include <cstdint>
namespace cg = cooperative_groups;

namespace pg8 {
#define PG8_LAS __attribute__((address_space(3)))
typedef unsigned short bf16_t;
typedef short bf16x8 __attribute__((ext_vector_type(8)));
typedef float f32x4 __attribute__((ext_vector_type(4)));
typedef unsigned u32x4 __attribute__((ext_vector_type(4)));
constexpr int BM = 256, BK = 64, HALF = 128, HTB = HALF * BK * 2  , STAGE_BYTES = 8 * HTB, NXCD = 8, WGM = 8;

__host__ __device__ __forceinline__ int lds_byte(int r, int c) { const int st = (r >> 4) * 2 + (c >> 5), rr = r & 15, cc = c & 31, ob = rr * 64 + cc * 2; return st * 1024 + (ob ^ (((ob >> 9) & 1) << 5)); }
__host__ __device__ __forceinline__ void stage_rc(int b, int& R, int& C) { const int st = b / 1024, sb = b % 1024, swz = sb ^ (((sb >> 9) & 1) << 5); R = (st >> 1) * 16 + swz / 64; C = (st & 1) * 32 + (swz % 64) / 2; }
__host__ __device__ __forceinline__ int perm32(int rho) { const int n = rho >> 4, i = rho & 15; return 8 * (i >> 2) + 4 * n + (i & 3); }

struct Unit { int pm, pn, aoff; };
struct Gemm { const bf16_t* A; const bf16_t* Bt; int M, N, K, lda; };

struct StaticOrder {
    int nM, nN, nwg, G, c;
    __host__ __device__ void init(int M, int N, int G_, int c_) { nM = M / BM; nN = N / BM; nwg = nM * nN; G = G_; c = c_; }
    __host__ __device__ bool next(int i, Unit& u) const {
        const long L = (long)i * G + c; if (L >= nwg) return false;
        int wgid = (int)L; { const int q = nwg / NXCD, r = nwg % NXCD, xcd = wgid % NXCD, off = wgid / NXCD; wgid = (xcd < r ? xcd * (q + 1) : r * (q + 1) + (xcd - r) * q) + off; }
        const int nig = WGM * nN, gid = wgid / nig, fm = gid * WGM, gsz = (nM - fm) < WGM ? (nM - fm) : WGM;
        u.pm = fm + ((wgid % nig) % gsz); u.pn = (wgid % nig) / gsz; u.aoff = 0; return true;
    }
    __device__ __forceinline__ void a_ready(const Unit&) const {}
    __device__ __forceinline__ void done(const Unit&) const {}
};

typedef float f32x2_t __attribute__((ext_vector_type(2))); typedef __bf16 bf16x2_t __attribute__((ext_vector_type(2))); typedef unsigned u32x2 __attribute__((ext_vector_type(2)));
__device__ __forceinline__ unsigned cvtpk(float lo, float hi) { f32x2_t v = {lo, hi}; bf16x2_t b = __builtin_convertvector(v, bf16x2_t); return __builtin_bit_cast(unsigned, b); }


template <int N> __device__ __forceinline__ float dpp_ror_add(float v) { return v + __builtin_bit_cast(float, __builtin_amdgcn_update_dpp(0, __builtin_bit_cast(int, v), 0x120 + N, 0xf, 0xf, false)); }
__device__ __forceinline__ float sum_xor16(float v) { return v + __shfl_xor(v, 16); }
__device__ __forceinline__ void swap32(float& a, float& b) { asm volatile("v_nop\n\tv_nop\n\tv_permlane32_swap_b32 %0, %1" : "+v"(a), "+v"(b)); }
__device__ __forceinline__ float sum_xor32(float v) { float a = v, b = v; swap32(a, b); return a + b; }
__device__ __forceinline__ float partner_xor32(float v, bool upper) { float a = v, b = v; swap32(a, b); return upper ? a : b; }
__device__ __forceinline__ float wave_sum_fast(float v) { v += __shfl_xor(v, 1); v += __shfl_xor(v, 2); v += __shfl_xor(v, 4); v += __shfl_xor(v, 8); v += __shfl_xor(v, 16); return sum_xor32(v); }
struct LatentOrder : StaticOrder {
    __host__ __device__ void init(int N, int G_, int c_) { StaticOrder::init(128 * BM, N, G_, c_); }
    __host__ __device__ bool next(int i, Unit& u) const { if (!StaticOrder::next(i, u)) return false; u.pm = u.pm + u.pm / 8 + 1; return true; }
};


struct XcdOrder {
    int tile0, p, kind, gsz, nN, pn0, n, nB, nC, PA, PB;
    __host__ __device__ void init(int c, int kind_, int nN_, int pn0_, int pos, int nA_, int PA_, int nB_, int PB_, int nC_) {
        const int tp = kind_ == 0 ? 16 : 2; tile0 = tp * (c & 7); gsz = tp < 8 ? tp : 8; p = pos; kind = kind_; nN = nN_; pn0 = pn0_; nB = nB_; nC = nC_; PA = PA_; PB = PB_;
        int n_ = nC_; if (pos < PB_) n_ = nB_; if (pos < PA_) n_ = nA_; n = n_; }
    __host__ __device__ bool next(int i, Unit& u) const {
        if (i >= n) return false;
        const int i1 = i < nC ? i : nC, i2 = i - nC < 0 ? 0 : (i - nC > nB - nC ? nB - nC : i - nC), i3 = i - nB < 0 ? 0 : i - nB;
        const int w = 32 * i1 + PB * i2 + PA * i3 + p;
        const int nig = gsz * nN, grp = w / nig, r = w % nig, t = tile0 + grp * gsz + r % gsz;
        u.pn = pn0 + r / gsz; u.pm = kind == 0 ? t + t / 8 + 1 : 9 * t; u.aoff = 0; return true;
    }
    __device__ __forceinline__ void a_ready(const Unit&) const {}
    __device__ __forceinline__ void done(const Unit&) const {}
};
struct EpiStore {
    static constexpr bool PERM = true, AFTER_DRAIN = false;
    bf16_t* O; int ldc;
    __device__ __forceinline__ void operator()(const f32x4 (&acc)[2][2][4][2], const Unit& u, int wr, int wc, int fr, int fq) const {
        const int row0 = u.pm * BM + wr * 64 + fr, col0 = u.pn * BM + wc * 32 + 8 * fq;
#pragma unroll
        for (int ai = 0; ai < 2; ++ai)
#pragma unroll
            for (int m = 0; m < 4; ++m) { bf16_t* rowp = O + (size_t)(row0 + ai * HALF + m * 16) * ldc + col0;
#pragma unroll
                for (int bj = 0; bj < 2; ++bj) { const f32x4 v0 = acc[ai][bj][m][0], v1 = acc[ai][bj][m][1];
                    u32x4 w; w.x = cvtpk(v0[0], v0[1]); w.y = cvtpk(v0[2], v0[3]); w.z = cvtpk(v1[0], v1[1]); w.w = cvtpk(v1[2], v1[3]);
                    *(u32x4*)(rowp + bj * HALF) = w; } }
    }
};
struct EpiRes {
    static constexpr bool PERM = false, AFTER_DRAIN = false;
    const float* base_lat; const float* base_ctx; float* out_lat; float* out_ctx; const float* modv_l; int chunk;
    __device__ __forceinline__ void operator()(const f32x4 (&acc)[2][2][4][2], const Unit& u, int wr, int wc, int fr, int fq) const {
        asm volatile("" : "+v"(fr), "+v"(fq) :: "memory");
        const int b = u.pm / 9, j = u.pm % 9;
        const float* __restrict__ bp; float* __restrict__ op; const float* gv;
        if (j == 0) { const size_t off = (size_t)b * 256 * 1024; bp = base_ctx + off; op = out_ctx + off; gv = modv_l + 16 * 6144 + chunk * 1024; }
        else { const size_t off = ((size_t)b * 2048 + (size_t)(j - 1) * 256) * 1024; bp = base_lat + off; op = out_lat + off; gv = modv_l + b * 6144 + chunk * 1024; }
        const int rl0 = wr * 64 + fr, col0 = u.pn * BM + wc * 32 + 4 * fq;
        f32x4 g[2][2];
#pragma unroll
        for (int bj = 0; bj < 2; ++bj)
#pragma unroll
            for (int n = 0; n < 2; ++n) g[bj][n] = *(const f32x4*)(gv + col0 + bj * HALF + n * 16);
#pragma unroll
        for (int ai = 0; ai < 2; ++ai)
#pragma unroll
            for (int m = 0; m < 4; ++m) { const size_t ro = (size_t)(rl0 + ai * HALF + m * 16) * 1024 + col0;
#pragma unroll
                for (int bj = 0; bj < 2; ++bj)
#pragma unroll
                    for (int n = 0; n < 2; ++n) { const f32x4 bs = *(const f32x4*)(bp + ro + bj * HALF + n * 16);
                        *(f32x4*)(op + ro + bj * HALF + n * 16) = bs + g[bj][n] * acc[ai][bj][m][n]; } }
    }
};
__device__ __forceinline__ float silu_mul(float g, float u) { return g * u * __builtin_amdgcn_rcpf(1.0f + __builtin_amdgcn_exp2f(-1.4426950408889634f * g)); }
struct EpiSwiGLU {
    static constexpr bool PERM = true, AFTER_DRAIN = false;
    bf16_t* H;
    __device__ __forceinline__ void operator()(const f32x4 (&acc)[2][2][4][2], const Unit& u, int wr, int wc, int fr, int fq) const {
        const int row0 = u.pm * BM + wr * 64 + fr, col0 = u.pn * HALF + wc * 32 + 8 * fq;
#pragma unroll
        for (int ai = 0; ai < 2; ++ai)
#pragma unroll
            for (int m = 0; m < 4; ++m) { bf16_t* rowp = H + (size_t)(row0 + ai * HALF + m * 16) * 2816 + col0;
                const f32x4 g0 = acc[ai][0][m][0], g1 = acc[ai][0][m][1], u0 = acc[ai][1][m][0], u1 = acc[ai][1][m][1];
                u32x4 w; w.x = cvtpk(silu_mul(g0[0], u0[0]), silu_mul(g0[1], u0[1])); w.y = cvtpk(silu_mul(g0[2], u0[2]), silu_mul(g0[3], u0[3]));
                w.z = cvtpk(silu_mul(g1[0], u1[0]), silu_mul(g1[1], u1[1])); w.w = cvtpk(silu_mul(g1[2], u1[2]), silu_mul(g1[3], u1[3]));
                *(u32x4*)rowp = w; }
    }
};

struct UpOrder : StaticOrder {
    __host__ __device__ bool next(int i, Unit& u) const { if (!StaticOrder::next(i, u)) return false; u.aoff = (u.pn < 3 ? 1536 : 1792) * 2; return true; }
};
struct EpiUp {
    static constexpr bool PERM = true, AFTER_DRAIN = false;
    bf16_t* Q; bf16_t* KV;
    const float* ssq_cq; const float* ssq_ckv;
    __device__ __forceinline__ void operator()(const f32x4 (&acc)[2][2][4][2], const Unit& u, int wr, int wc, int fr, int fq) const {
        asm volatile("" : "+v"(fr), "+v"(fq) :: "memory");
        const bool isq = u.pn < 3; bf16_t* O = isq ? Q : KV; const int ldc = isq ? 768 : 1024;
        const int row0 = u.pm * BM + wr * 64 + fr, col0 = (isq ? u.pn : u.pn - 3) * BM + wc * 32 + 8 * fq;
        const float* sq = isq ? ssq_cq : ssq_ckv; const float inv = isq ? (1.0f / 256.0f) : (1.0f / 128.0f);
        float rs[2][4];
#pragma unroll
        for (int ai = 0; ai < 2; ++ai)
#pragma unroll
            for (int m = 0; m < 4; ++m) rs[ai][m] = 1.0f / sqrtf(sq[row0 + ai * HALF + m * 16] * inv + 1e-6f);
#pragma unroll
        for (int ai = 0; ai < 2; ++ai)
#pragma unroll
            for (int m = 0; m < 4; ++m) { bf16_t* rowp = O + (size_t)(row0 + ai * HALF + m * 16) * ldc + col0;
#pragma unroll
                for (int bj = 0; bj < 2; ++bj) { const f32x4 v0 = acc[ai][bj][m][0] * rs[ai][m], v1 = acc[ai][bj][m][1] * rs[ai][m];
                    u32x4 w; w.x = cvtpk(v0[0], v0[1]); w.y = cvtpk(v0[2], v0[3]); w.z = cvtpk(v1[0], v1[1]); w.w = cvtpk(v1[2], v1[3]);
                    *(u32x4*)(rowp + bj * HALF) = w; } }
    }
};
struct ProjGroup { int kind; const float* gain; float oscale; int rope; float* ssq; };
template <bool NORMIN, class GroupFn> struct EpiProj {
    static constexpr bool PERM = true, AFTER_DRAIN = false;
    bf16_t* O; int ldc;
    const float* ssq_in; const float* shw; int shw_ld;
    const float* ropet;
    GroupFn gf;
    __device__ __forceinline__ void operator()(const f32x4 (&acc)[2][2][4][2], const Unit& u, int wr, int wc, int fr, int fq) const {
        asm volatile("" : "+v"(fr), "+v"(fq) :: "memory");
        const int g = 4 * u.pn + wc; const ProjGroup G = gf(g);
        const int b = u.pm / 9, j = u.pm % 9; const bool lat = j != 0; const int midx = lat ? b : 16;
        const int row0 = u.pm * BM + wr * 64 + fr;
        f32x4 shv[2][2], gn[2][2]; float rin[2][4];
#pragma unroll
        for (int bj = 0; bj < 2; ++bj)
#pragma unroll
            for (int n = 0; n < 2; ++n) { shv[bj][n] = NORMIN ? *(const f32x4*)(shw + (size_t)midx * shw_ld + u.pn * BM + bj * HALF + wc * 32 + 8 * fq + 4 * n) : (f32x4){0.f, 0.f, 0.f, 0.f};
                gn[bj][n] = (G.kind == 1) ? *(const f32x4*)(G.gain + 32 * bj + 8 * fq + 4 * n) : (f32x4){1.f, 1.f, 1.f, 1.f}; }
#pragma unroll
        for (int ai = 0; ai < 2; ++ai)
#pragma unroll
            for (int m = 0; m < 4; ++m) rin[ai][m] = NORMIN ? 1.0f / sqrtf(ssq_in[row0 + ai * HALF + m * 16] * (1.0f / 1024.0f) + 1e-6f) : 1.0f;
        if (!NORMIN) { const float dl = ropet[fq]; asm volatile("" :: "v"(dl)); }
        const bool do_rope = (G.kind == 1) && G.rope && lat;
        float invr[2][4];
#pragma unroll
        for (int n = 0; n < 2; ++n)
#pragma unroll
            for (int i = 0; i < 4; ++i) invr[n][i] = __builtin_amdgcn_exp2f(-(float)(8 * (fq & 1) + 4 * n + i) * 0.8304820237218405f) * 0.15915494309189535f;
#pragma unroll
        for (int ai = 0; ai < 2; ++ai)
#pragma unroll
            for (int m = 0; m < 4; ++m) {
                const int row = row0 + ai * HALF + m * 16;
                f32x4 v[2][2];
#pragma unroll
                for (int bj = 0; bj < 2; ++bj)
#pragma unroll
                    for (int n = 0; n < 2; ++n) v[bj][n] = NORMIN ? acc[ai][bj][m][n] * rin[ai][m] + shv[bj][n] : acc[ai][bj][m][n];
                if (G.kind != 0) {
                    float ss = 0.f;
#pragma unroll
                    for (int bj = 0; bj < 2; ++bj)
#pragma unroll
                        for (int n = 0; n < 2; ++n) ss += (v[bj][n][0] * v[bj][n][0] + v[bj][n][1] * v[bj][n][1]) + (v[bj][n][2] * v[bj][n][2] + v[bj][n][3] * v[bj][n][3]);
                    ss = sum_xor32(sum_xor16(ss));
                    if (G.kind == 2) { if (fq == 0) atomicAdd(G.ssq + row, ss); }
                    else {
                        const float rstd = 1.0f / sqrtf(ss * (1.0f / 64.0f) + 1e-6f);
#pragma unroll
                        for (int bj = 0; bj < 2; ++bj)
#pragma unroll
                            for (int n = 0; n < 2; ++n) v[bj][n] = v[bj][n] * rstd * gn[bj][n];
                        if (do_rope) {
                            const float prow = (float)(4 * (j - 1) + 2 * ai + wr), pcol = (float)(16 * m + fr);
#pragma unroll
                            for (int bj = 0; bj < 2; ++bj)
#pragma unroll
                                for (int n = 0; n < 2; ++n)
#pragma unroll
                                    for (int i = 0; i < 4; ++i) { const float rev = (bj == 0 ? prow : pcol) * invr[n][i], frc = rev - floorf(rev);
                                        const float cs = __builtin_amdgcn_cosf(frc), sn = __builtin_amdgcn_sinf(frc), x = v[bj][n][i], pv = partner_xor32(x, (fq & 2) != 0);
                                        v[bj][n][i] = (fq & 2) ? (pv * sn + x * cs) : (x * cs - pv * sn); }
                        }
#pragma unroll
                        for (int bj = 0; bj < 2; ++bj)
#pragma unroll
                            for (int n = 0; n < 2; ++n) v[bj][n] = v[bj][n] * G.oscale;
                    }
                }
                bf16_t* rowp = O + (size_t)row * ldc + 64 * g + 8 * fq;
#pragma unroll
                for (int bj = 0; bj < 2; ++bj) { u32x4 w; w.x = cvtpk(v[bj][0][0], v[bj][0][1]); w.y = cvtpk(v[bj][0][2], v[bj][0][3]); w.z = cvtpk(v[bj][1][0], v[bj][1][1]); w.w = cvtpk(v[bj][1][2], v[bj][1][3]);
                    *(u32x4*)(rowp + 32 * bj) = w; }
            }
    }
};
template <bool BASE_F32, bool FINAL> struct EpiRes3 {
    static constexpr bool PERM = false, AFTER_DRAIN = false;
    const float* base_lat; const float* base_ctx; bf16_t* xr; float* out_lat; const float* modv_l; int chunk;
    bf16_t* xn; float* ssq; const float* gain_n; const float* modv_n; int chunk_n;
    __device__ __forceinline__ void operator()(const f32x4 (&acc)[2][2][4][2], const Unit& u, int wr, int wc, int fr, int fq) const {
        asm volatile("" : "+v"(fr), "+v"(fq) :: "memory");
        const int b = u.pm / 9, j = u.pm % 9; const int midx = (j == 0) ? 16 : b;
        const float* __restrict__ bp = (j == 0) ? base_ctx + (size_t)b * 256 * 1024 : base_lat + ((size_t)b * 2048 + (size_t)(j - 1) * 256) * 1024;
        float* __restrict__ op = out_lat + ((size_t)b * 2048 + (size_t)(j - 1) * 256) * 1024;
        bf16_t* __restrict__ xrp = xr + (size_t)u.pm * BM * 1024;
        bf16_t* __restrict__ xnp = xn + (size_t)u.pm * BM * 1024;
        const float* gv = modv_l + midx * 6144 + chunk * 1024; const float* sv = modv_n + midx * 6144 + chunk_n * 1024;
        const int rl0 = wr * 64 + fr, col0 = u.pn * BM + wc * 32 + 4 * fq;
        float ss[2][4];
#pragma unroll
        for (int ai = 0; ai < 2; ++ai)
#pragma unroll
            for (int m = 0; m < 4; ++m) ss[ai][m] = 0.f;
#pragma unroll
        for (int bj = 0; bj < 2; ++bj)
#pragma unroll
            for (int n = 0; n < 2; ++n) { const int col = col0 + bj * HALF + n * 16;
                const f32x4 g4v = *(const f32x4*)(gv + col);
                f32x4 gs4v = (f32x4){0.f, 0.f, 0.f, 0.f}; if (!FINAL) gs4v = *(const f32x4*)(gain_n + col) * (*(const f32x4*)(sv + col) + 1.0f);
                f32x4 bs[2][4];
#pragma unroll
                for (int ai = 0; ai < 2; ++ai)
#pragma unroll
                    for (int m = 0; m < 4; ++m) { const size_t ro = (size_t)(rl0 + ai * HALF + m * 16) * 1024 + col;
                        if (BASE_F32) bs[ai][m] = __builtin_nontemporal_load((const f32x4*)(bp + ro));
                        else { const u32x2 w = *(const u32x2*)(xrp + ro); bs[ai][m] = (f32x4){__uint_as_float(w.x << 16), __uint_as_float(w.x & 0xffff0000u), __uint_as_float(w.y << 16), __uint_as_float(w.y & 0xffff0000u)}; } }
#pragma unroll
                for (int ai = 0; ai < 2; ++ai)
#pragma unroll
                    for (int m = 0; m < 4; ++m) { const size_t ro = (size_t)(rl0 + ai * HALF + m * 16) * 1024 + col;
                        const f32x4 x = bs[ai][m] + g4v * acc[ai][bj][m][n];
                        if (FINAL) __builtin_nontemporal_store(x, (f32x4*)(op + ro));
                        else { u32x2 w; w.x = cvtpk(x[0], x[1]); w.y = cvtpk(x[2], x[3]); *(u32x2*)(xrp + ro) = w;
                            ss[ai][m] += (x[0] * x[0] + x[1] * x[1]) + (x[2] * x[2] + x[3] * x[3]);
                            const f32x4 h = x * gs4v; u32x2 w2; w2.x = cvtpk(h[0], h[1]); w2.y = cvtpk(h[2], h[3]);
                            *(u32x2*)(xnp + ro) = w2; } } }
        if (!FINAL) {
#pragma unroll
            for (int ai = 0; ai < 2; ++ai)
#pragma unroll
                for (int m = 0; m < 4; ++m) { const float s2 = sum_xor32(sum_xor16(ss[ai][m])); if (fq == 0) atomicAdd(ssq + u.pm * BM + rl0 + ai * HALF + m * 16, s2); } }
    }
};
struct EpiSwiGLU2 {
    static constexpr bool PERM = true, AFTER_DRAIN = false;
    bf16_t* H; const float* ssq_in; const float* shw;
    __device__ __forceinline__ void operator()(const f32x4 (&acc)[2][2][4][2], const Unit& u, int wr, int wc, int fr, int fq) const {
        asm volatile("" : "+v"(fr), "+v"(fq) :: "memory");
        const int b = u.pm / 9, j = u.pm % 9; const int midx = (j == 0) ? 16 : b;
        const int row0 = u.pm * BM + wr * 64 + fr, col0 = u.pn * HALF + wc * 32 + 8 * fq;
        const float* sp = shw + (size_t)midx * 5632 + u.pn * BM + wc * 32 + 8 * fq;
        const f32x4 sg0 = *(const f32x4*)(sp), sg1 = *(const f32x4*)(sp + 4), su0 = *(const f32x4*)(sp + HALF), su1 = *(const f32x4*)(sp + HALF + 4);
        float rinv[2][4];
#pragma unroll
        for (int ai = 0; ai < 2; ++ai)
#pragma unroll
            for (int m = 0; m < 4; ++m) rinv[ai][m] = 1.0f / sqrtf(ssq_in[row0 + ai * HALF + m * 16] * (1.0f / 1024.0f) + 1e-6f);
#pragma unroll
        for (int ai = 0; ai < 2; ++ai)
#pragma unroll
            for (int m = 0; m < 4; ++m) { const int row = row0 + ai * HALF + m * 16; bf16_t* rowp = H + (size_t)row * 3072 + col0;
                const float rin = rinv[ai][m];
                const f32x4 g0 = acc[ai][0][m][0] * rin + sg0, g1 = acc[ai][0][m][1] * rin + sg1, u0 = acc[ai][1][m][0] * rin + su0, u1 = acc[ai][1][m][1] * rin + su1;
                u32x4 w; w.x = cvtpk(silu_mul(g0[0], u0[0]), silu_mul(g0[1], u0[1])); w.y = cvtpk(silu_mul(g0[2], u0[2]), silu_mul(g0[3], u0[3]));
                w.z = cvtpk(silu_mul(g1[0], u1[0]), silu_mul(g1[1], u1[1])); w.w = cvtpk(silu_mul(g1[2], u1[2]), silu_mul(g1[3], u1[3]));
                *(u32x4*)rowp = w; }
    }
};

template <class Epi, class Sched, bool ALIGN_EPI = false, bool SP2 = false>
__device__ __forceinline__ void gemm_phase(PG8_LAS unsigned char* lds, const Gemm g, const Sched& S, const Epi& E) {
    const int tid = threadIdx.x, wid = __builtin_amdgcn_readfirstlane(tid >> 6), lane = tid & 63, wr = wid >> 2, wc = wid & 3, fr = lane & 15, fq = lane >> 4;
    const int K = g.K, nt = K / BK;
    unsigned voffA[2], voffB[2];
#pragma unroll
    for (int i = 0; i < 2; ++i) { int R, C; stage_rc(tid * 16 + i * 8192, R, C); const int Rb = Epi::PERM ? ((R & ~31) + perm32(R & 31)) : R;
        voffA[i] = (unsigned)(R * g.lda + C) * 2u; voffB[i] = (unsigned)(Rb * K + C) * 2u; }
    const size_t kstep = (size_t)(BK * 2);
    const size_t hstepB = (size_t)HALF * K * 2, hstepA = (size_t)HALF * g.lda * 2;
    const size_t tstepB = 2 * hstepB, tstepA = 2 * hstepA;
    const unsigned ldsw = (unsigned)wid * 1024u;
    const int aoff = lds_byte(wr * 64 + fr, fq * 8), boff = lds_byte(wc * 32 + fr, fq * 8);
#define PG8_SA(b, h) (((b) * 2 + (h)) * HTB)
#define PG8_SB(b, h) ((4 + (b) * 2 + (h)) * HTB)
#define PG8_STAGE(bufoff, gbase, voff) do { _Pragma("unroll") for (int _i = 0; _i < 2; ++_i) \
        __builtin_amdgcn_global_load_lds((const unsigned*)((const char*)(gbase) + (voff)[_i]), (PG8_LAS unsigned*)(lds + (bufoff) + ldsw + _i * 8192), 16, 0, 0); } while (0)
#define PG8_LDA(dst, b, h) do { _Pragma("unroll") for (int m = 0; m < 4; ++m) _Pragma("unroll") for (int k = 0; k < 2; ++k) dst[m][k] = *(const PG8_LAS bf16x8*)(lds + PG8_SA(b, h) + aoff + m * 2048 + k * 1024); } while (0)
#define PG8_LDB(dst, b, h) do { _Pragma("unroll") for (int n = 0; n < 2; ++n) _Pragma("unroll") for (int k = 0; k < 2; ++k) dst[n][k] = *(const PG8_LAS bf16x8*)(lds + PG8_SB(b, h) + boff + n * 2048 + k * 1024); } while (0)
#define PG8_MMA(ai, bj, At, Bt) do { __builtin_amdgcn_s_setprio(1); _Pragma("unroll") for (int m = 0; m < 4; ++m) _Pragma("unroll") for (int n = 0; n < 2; ++n) _Pragma("unroll") for (int k = 0; k < 2; ++k) \
        acc[ai][bj][m][n] = __builtin_amdgcn_mfma_f32_16x16x32_bf16(Bt[n][k], At[m][k], acc[ai][bj][m][n], 0, 0, 0); __builtin_amdgcn_s_setprio(0); } while (0)
#define PG8_WAIT_V(n) asm volatile("s_waitcnt vmcnt(" #n ")" ::: "memory")
#define PG8_WAIT_L(n) asm volatile("s_waitcnt lgkmcnt(" #n ")" ::: "memory")
#define PG8_BAR __builtin_amdgcn_s_barrier()
#define PG8_SCHED __builtin_amdgcn_sched_barrier(0)
    Unit cur, nxt; int ui = 0;
    if (!S.next(0, cur)) return;
    f32x4 acc[2][2][4][2];
#pragma unroll
    for (int a = 0; a < 2; ++a)
#pragma unroll
        for (int b = 0; b < 2; ++b)
#pragma unroll
            for (int m = 0; m < 4; ++m)
#pragma unroll
                for (int n = 0; n < 2; ++n) acc[a][b][m][n] = (f32x4){0.f, 0.f, 0.f, 0.f};
    bf16x8 At[4][2], B0[2][2], B1[2][2];
    const char* cA = (const char*)g.A + (size_t)cur.pm * tstepA + cur.aoff; const char* cB = (const char*)g.Bt + (size_t)cur.pn * tstepB;
    S.a_ready(cur);
    if constexpr (SP2) {
        PG8_STAGE(PG8_SB(0, 0), cB, voffB); PG8_STAGE(PG8_SB(0, 1), cB + hstepB, voffB); PG8_STAGE(PG8_SA(0, 0), cA, voffA); PG8_STAGE(PG8_SA(0, 1), cA + hstepA, voffA);
        if (wr == 1) PG8_BAR;
        PG8_WAIT_V(2); PG8_BAR;
        PG8_STAGE(PG8_SB(1, 0), cB + kstep, voffB); PG8_STAGE(PG8_SA(1, 0), cA + kstep, voffA); PG8_STAGE(PG8_SB(1, 1), cB + hstepB + kstep, voffB);
        PG8_WAIT_V(6); PG8_BAR;
    } else {
        PG8_STAGE(PG8_SB(0, 0), cB, voffB); PG8_STAGE(PG8_SA(0, 0), cA, voffA); PG8_STAGE(PG8_SB(0, 1), cB + hstepB, voffB); PG8_STAGE(PG8_SA(0, 1), cA + hstepA, voffA);
        if (wr == 1) PG8_BAR;
        PG8_WAIT_V(4); PG8_BAR;
        PG8_STAGE(PG8_SB(1, 0), cB + kstep, voffB); PG8_STAGE(PG8_SA(1, 0), cA + kstep, voffA); PG8_STAGE(PG8_SB(1, 1), cB + hstepB + kstep, voffB);
        PG8_WAIT_V(6); PG8_BAR;
    }
    for (;;) {
        const bool has_next = S.next(ui + 1, nxt);
        const char* nA = has_next ? (const char*)g.A + (size_t)nxt.pm * tstepA + nxt.aoff : cA; const char* nB = has_next ? (const char*)g.Bt + (size_t)nxt.pn * tstepB : cB;
        for (int t = 0; t < nt; t += 2) {
            const bool last = (t == nt - 2);
            const char* a1 = cA + (size_t)(t + 1) * kstep;
            const char* a2 = last ? nA : cA + (size_t)(t + 2) * kstep; const char* b2 = last ? nB : cB + (size_t)(t + 2) * kstep;
            const char* a3 = a2 + kstep; const char* b3 = b2 + kstep;
            if (last && has_next) S.a_ready(nxt);
            if constexpr (SP2) {
            PG8_LDB(B0, 0, 0); PG8_LDB(B1, 0, 1); PG8_SCHED; PG8_LDA(At, 0, 0); PG8_STAGE(PG8_SA(1, 1), a1 + hstepA, voffA);
            PG8_WAIT_V(8); PG8_WAIT_L(0); PG8_BAR; PG8_MMA(0, 0, At, B0); PG8_MMA(0, 1, At, B1); PG8_BAR; PG8_SCHED;
            PG8_LDA(At, 0, 1); PG8_STAGE(PG8_SB(0, 0), b2, voffB); PG8_STAGE(PG8_SB(0, 1), b2 + hstepB, voffB); PG8_STAGE(PG8_SA(0, 0), a2, voffA);
            PG8_WAIT_V(8); PG8_WAIT_L(0); PG8_BAR; PG8_MMA(1, 0, At, B0); PG8_MMA(1, 1, At, B1); PG8_BAR; PG8_SCHED;
            PG8_LDB(B0, 1, 0); PG8_LDB(B1, 1, 1); PG8_SCHED; PG8_LDA(At, 1, 0); PG8_STAGE(PG8_SA(0, 1), a2 + hstepA, voffA);
            PG8_WAIT_V(8); PG8_WAIT_L(0); PG8_BAR; PG8_MMA(0, 0, At, B0); PG8_MMA(0, 1, At, B1); PG8_BAR; PG8_SCHED;
            PG8_LDA(At, 1, 1); PG8_STAGE(PG8_SB(1, 0), b3, voffB); PG8_STAGE(PG8_SB(1, 1), b3 + hstepB, voffB); PG8_STAGE(PG8_SA(1, 0), a3, voffA);
            PG8_WAIT_V(8); PG8_WAIT_L(0); PG8_BAR; PG8_MMA(1, 0, At, B0); PG8_MMA(1, 1, At, B1); PG8_BAR; PG8_SCHED;
            } else {
            PG8_LDB(B0, 0, 0); PG8_SCHED; PG8_LDA(At, 0, 0); PG8_STAGE(PG8_SA(1, 1), a1 + hstepA, voffA);
            PG8_WAIT_L(8); PG8_BAR; PG8_WAIT_L(0); PG8_MMA(0, 0, At, B0); PG8_BAR; PG8_SCHED;
            PG8_LDB(B1, 0, 1); PG8_STAGE(PG8_SB(0, 0), b2, voffB);
            PG8_BAR; PG8_WAIT_L(0); PG8_MMA(0, 1, At, B1); PG8_BAR;
            PG8_LDA(At, 0, 1); PG8_STAGE(PG8_SA(0, 0), a2, voffA);
            PG8_BAR; PG8_WAIT_L(0); PG8_MMA(1, 0, At, B0); PG8_BAR; PG8_SCHED;
            PG8_STAGE(PG8_SB(0, 1), b2 + hstepB, voffB);
            PG8_WAIT_V(6); PG8_BAR; PG8_MMA(1, 1, At, B1); PG8_BAR;
            PG8_LDB(B0, 1, 0); PG8_SCHED; PG8_LDA(At, 1, 0); PG8_STAGE(PG8_SA(0, 1), a2 + hstepA, voffA);
            PG8_WAIT_L(8); PG8_BAR; PG8_WAIT_L(0); PG8_MMA(0, 0, At, B0); PG8_BAR; PG8_SCHED;
            PG8_LDB(B1, 1, 1); PG8_STAGE(PG8_SB(1, 0), b3, voffB);
            PG8_BAR; PG8_WAIT_L(0); PG8_MMA(0, 1, At, B1); PG8_BAR;
            PG8_LDA(At, 1, 1); PG8_STAGE(PG8_SA(1, 0), a3, voffA);
            PG8_BAR; PG8_WAIT_L(0); PG8_MMA(1, 0, At, B0); PG8_BAR; PG8_SCHED;
            PG8_STAGE(PG8_SB(1, 1), b3 + hstepB, voffB);
            PG8_WAIT_V(6); PG8_BAR; PG8_MMA(1, 1, At, B1); PG8_BAR;
            }
        }
        if constexpr (ALIGN_EPI) { if (wr == 0) PG8_BAR; }
        if constexpr (!Epi::AFTER_DRAIN) { E(acc, cur, wr, wc, fr, fq); S.done(cur); }
        if (!has_next) break;
#pragma unroll
        for (int a = 0; a < 2; ++a)
#pragma unroll
            for (int b = 0; b < 2; ++b)
#pragma unroll
                for (int m = 0; m < 4; ++m)
#pragma unroll
                    for (int n = 0; n < 2; ++n) acc[a][b][m][n] = (f32x4){0.f, 0.f, 0.f, 0.f};
        cur = nxt; cA = nA; cB = nB; ++ui;
        if constexpr (ALIGN_EPI) { if (wr == 1) PG8_BAR; }
    }
    PG8_WAIT_V(0);
    if constexpr (!ALIGN_EPI) { if (wr == 0) PG8_BAR; }
    PG8_BAR;
    if constexpr (Epi::AFTER_DRAIN) { E.fused(acc, cur, wr, wc, fr, fq, lds, wid, lane); S.done(cur); }
#undef PG8_SA
#undef PG8_SB
#undef PG8_STAGE
#undef PG8_LDA
#undef PG8_LDB
#undef PG8_MMA
#undef PG8_WAIT_V
#undef PG8_WAIT_L
#undef PG8_BAR
#undef PG8_SCHED
}
}

constexpr int DM = 1024, NBATCH = 16, SEQ = 2048, CTXL = 256, TU = SEQ + CTXL  , MROWS = NBATCH * TU  ;
constexpr int EVN = 1984, EVNP = 2048, DFF = 2816, ODN = 3072, HIDP = 3072  ;
constexpr float EPS = 1e-6f, LOG2E = 1.4426950408889634f;
constexpr float QS_DA = 0.125f * LOG2E, QS_NA = 0.125f * LOG2E, QS_MLA = 0.07216878364870322f * LOG2E;
constexpr float LAM_INIT0 = 0.2f;

constexpr size_t MiB = 1u << 20;
constexpr size_t WS_CTL = 0, CTL_ZERO_BYTES = 1 * MiB;
constexpr size_t WS_MODV = 1 * MiB;
constexpr size_t WS_SMALL = 2 * MiB;
constexpr size_t WS_SSQ = WS_SMALL + 65536, SSQ_STRIDE = 163840;
constexpr size_t WS_WUQ = 3 * MiB;
constexpr size_t WS_WUKV = WS_WUQ + 768 * 256 * 2;
constexpr size_t WS_WEV = 5 * MiB;
constexpr size_t WS_WO = 9 * MiB;
constexpr size_t WS_WOD = 13 * MiB;
constexpr size_t WS_WFI = 19 * MiB;
constexpr size_t WS_WFO = 41 * MiB;
constexpr size_t WS_XR16 = 53 * MiB;
constexpr size_t WS_XN = 125 * MiB;
constexpr size_t WS_KVRAW = WS_XN;
constexpr size_t WS_Y = 197 * MiB;
constexpr size_t WS_REG = 269 * MiB;
constexpr size_t WS_QRAW = WS_REG + 144 * MiB;
constexpr size_t WS_SHW = 485 * MiB;
constexpr size_t SHW_F0 = 0, SHW_OD = 17 * 5632 * 4, SHW_F1 = SHW_OD + 17 * 3072 * 4;
constexpr size_t WS_END = 487 * MiB;

constexpr int LDS_BYTES = 147456;
#define LAS __attribute__((address_space(3)))
typedef unsigned short bf16_t;
typedef unsigned u32x4 __attribute__((ext_vector_type(4)));
typedef unsigned u32x2 __attribute__((ext_vector_type(2)));
typedef float f32x4 __attribute__((ext_vector_type(4)));
typedef float f32x16 __attribute__((ext_vector_type(16)));
typedef short bf16x8 __attribute__((ext_vector_type(8)));
typedef short s16x4 __attribute__((ext_vector_type(4)));
using pg8::cvtpk;

struct Params {
    const float* in[30];
    float* out; unsigned char* ws;
    int ph_lo, ph_hi, abl, pad;
};
struct Frame {
    LAS unsigned char* lds;
    int tid, lane, wave, G, bid, abl;
    float* out; unsigned char* ws;
};
__device__ __forceinline__ const float* inptr(const Params& p, int i) { asm volatile("" : "+s"(i)); return p.in[i]; }
#define INP(i) inptr(p, (i))
#define IN_X 0
#define IN_C 1
#define IN_CTX 2
#define IN_CCTX 3
#define IN_MODW 4
#define IN_MODB 5
#define IN_NMIX 6
#define IN_NFFN 7
#define IN_WOUT 8
#define IN_FWIN 9
#define IN_FWOUT 10
#define IN_EVW 11
#define IN_DAQG 12
#define IN_DAKG 13
#define IN_LQ1 14
#define IN_LK1 15
#define IN_LQ2 16
#define IN_LK2 17
#define IN_DAOG 18
#define IN_MQAG 19
#define IN_WUQ 20
#define IN_MKVAG 21
#define IN_WUKV 22
#define IN_MQG 23
#define IN_MKG 24
#define IN_MKRG 25
#define IN_ODW 26
#define IN_NAQG 27
#define IN_NAKG 28
#define IN_RPB 29

__device__ __forceinline__ float wave_sum(float v) { return pg8::wave_sum_fast(v); }
__device__ __forceinline__ float bf_lo(unsigned w) { return __uint_as_float(w << 16); }
__device__ __forceinline__ float bf_hi(unsigned w) { return __uint_as_float(w & 0xffff0000u); }
__device__ __forceinline__ void unpack8(const u32x4 w, float (&v)[8]) { v[0] = bf_lo(w.x); v[1] = bf_hi(w.x); v[2] = bf_lo(w.y); v[3] = bf_hi(w.y); v[4] = bf_lo(w.z); v[5] = bf_hi(w.z); v[6] = bf_lo(w.w); v[7] = bf_hi(w.w); }
__device__ __forceinline__ u32x4 pack8(const float (&v)[8]) { u32x4 w; w.x = cvtpk(v[0], v[1]); w.y = cvtpk(v[2], v[3]); w.z = cvtpk(v[4], v[5]); w.w = cvtpk(v[6], v[7]); return w; }
#define LDS_WAIT() asm volatile("s_waitcnt lgkmcnt(0)" ::: "memory")

__device__ __forceinline__ void transpose_item(const float* W, int N, bf16_t* WT, int ldt, int dst_row, int k0, int n0, const float* kscale, LAS float* scr, int lane) {
#pragma unroll 8
    for (int i = 0; i < 32; ++i) { const int kk = 2 * i + (lane >> 5); float v = __builtin_nontemporal_load(W + (size_t)(k0 + kk) * N + n0 + (lane & 31));        if (kscale) v *= kscale[k0 + kk]; scr[kk * 33 + (lane & 31)] = v; }
    LDS_WAIT(); asm volatile("" ::: "memory");
    const int c = lane & 7;
#pragma unroll
    for (int j = 0; j < 4; ++j) { const int n = (lane >> 3) + 8 * j; const LAS float* s = scr + (8 * c) * 33 + n;
        u32x4 o; o.x = cvtpk(s[0 * 33], s[1 * 33]); o.y = cvtpk(s[2 * 33], s[3 * 33]); o.z = cvtpk(s[4 * 33], s[5 * 33]); o.w = cvtpk(s[6 * 33], s[7 * 33]);
        *(u32x4*)(WT + (size_t)(dst_row + n) * ldt + k0 + 8 * c) = o; }
    LDS_WAIT(); asm volatile("" ::: "memory");
}
__host__ __device__ __forceinline__ int head_row(int L) { return 256 * (L / 256) + 128 * ((L % 64) / 32) + 32 * ((L % 256) / 64); }
__device__ __forceinline__ void p0_prologue(Frame& F, const Params& p) {
    float* modv = (float*)(F.ws + WS_MODV);
    LAS float* condl = (LAS float*)F.lds;
    LAS float* red = (LAS float*)(F.lds + 17 * 1024 * 4);
    for (int e = F.tid; e < 17 * 1024; e += 512) { const int i = e >> 10, k = e & 1023; const float c = (i < 16) ? INP(IN_C)[i * 1024 + k] : INP(IN_CCTX)[k]; condl[e] = c / (1.0f + __expf(-c)); }
    __syncthreads();
    for (int item = F.bid; item < 256; item += F.G) {
        const int l = item >> 7, cg_ = item & 127, col = cg_ * 48 + (F.lane < 48 ? F.lane : 0);
        float acc[17];
#pragma unroll
        for (int i = 0; i < 17; ++i) acc[i] = 0.f;
        const float* wp = INP(IN_MODW) + ((size_t)l * 1024 + F.wave * 128) * 6144 + col;
        const LAS float* cl = condl + F.wave * 128;
#pragma unroll 8
        for (int k = 0; k < 128; ++k) { const float wv = __builtin_nontemporal_load(wp + (size_t)k * 6144);
#pragma unroll
            for (int i = 0; i < 17; ++i) acc[i] += cl[i * 1024 + k] * wv; }
        if (F.lane < 48) {
#pragma unroll
            for (int i = 0; i < 17; ++i) red[(F.wave * 17 + i) * 48 + F.lane] = acc[i]; }
        __syncthreads();
        for (int t = F.tid; t < 17 * 48; t += 512) { const int i = t / 48, cl2 = t % 48; float s = 0.f;
#pragma unroll
            for (int w = 0; w < 8; ++w) s += red[(w * 17 + i) * 48 + cl2];
            modv[((size_t)l * 17 + i) * 6144 + cg_ * 48 + cl2] = s + INP(IN_MODB)[l * 6144 + cg_ * 48 + cl2]; }
        __syncthreads();
    }
    { float* z = (float*)(F.ws + WS_SSQ); for (int e = F.bid * 512 + F.tid; e < (int)(5 * SSQ_STRIDE / 4); e += F.G * 512) z[e] = 0.f; }
    { const int gt = F.bid * 512 + F.tid; if (gt < 1024) { const int pos = gt >> 4, f = gt & 15; const float inv = __builtin_amdgcn_exp2f(-(float)f * 0.8304820237218405f);
          const float rev = (float)pos * inv * 0.15915494309189535f, fr = rev - floorf(rev);
          float* rt = (float*)(F.ws + WS_SMALL); rt[2 * gt] = __builtin_amdgcn_cosf(fr); rt[2 * gt + 1] = __builtin_amdgcn_sinf(fr); } }
    LAS float* scr = (LAS float*)(F.lds + F.wave * 16384);
    const int gw = F.bid * 8 + F.wave, NGW = F.G * 8;
    constexpr int I_EV = 16 * 62, I_O = 16 * 32, I_FI = 16 * 176, I_FO = 44 * 32, I_OD = 16 * 96, I_UQ = 4 * 24, I_UKV = 2 * 32;
    constexpr int NITEMS = I_EV + 2 * I_O + 2 * I_FI + 2 * I_FO + I_OD + I_UQ + I_UKV;
    for (int it = gw; it < NITEMS; it += NGW) {
        int r = it;
        if (r < I_EV) { const int kb = r / 62, nb = r % 62; transpose_item(INP(IN_EVW), EVN, (bf16_t*)(F.ws + WS_WEV), 1024, head_row(32 * nb), 64 * kb, 32 * nb, nullptr, scr, F.lane); continue; } r -= I_EV;
        if (r < 2 * I_O) { const int l = r / I_O; r %= I_O; const int kb = r / 32, nb = r % 32; transpose_item(INP(IN_WOUT) + (size_t)l * 1024 * 1024, 1024, (bf16_t*)(F.ws + WS_WO) + (size_t)l * 1024 * 1024, 1024, 32 * nb, 64 * kb, 32 * nb, nullptr, scr, F.lane); continue; } r -= 2 * I_O;
        if (r < 2 * I_FI) { const int l = r / I_FI; r %= I_FI; const int kb = r / 176, nb = r % 176; const int n0 = 32 * nb, up = n0 >= DFF ? 1 : 0, jj = n0 - up * DFF;
            const int drow = (jj / 128) * 256 + up * 128 + (jj % 128);
            transpose_item(INP(IN_FWIN) + (size_t)l * 1024 * 5632, 5632, (bf16_t*)(F.ws + WS_WFI) + (size_t)l * 5632 * 1024, 1024, drow, 64 * kb, n0, nullptr, scr, F.lane); continue; } r -= 2 * I_FI;
        if (r < 2 * I_FO) { const int l = r / I_FO; r %= I_FO; const int kb = r / 32, nb = r % 32; transpose_item(INP(IN_FWOUT) + (size_t)l * DFF * 1024, 1024, (bf16_t*)(F.ws + WS_WFO + (size_t)l * 6 * MiB), DFF, 32 * nb, 64 * kb, 32 * nb, nullptr, scr, F.lane); continue; } r -= 2 * I_FO;
        if (r < I_OD) { const int kb = r / 96, nb = r % 96; transpose_item(INP(IN_ODW), ODN, (bf16_t*)(F.ws + WS_WOD), 1024, head_row(32 * nb), 64 * kb, 32 * nb, nullptr, scr, F.lane); continue; } r -= I_OD;
        if (r < I_UQ) { const int kb = r / 24, nb = r % 24; transpose_item(INP(IN_WUQ), 768, (bf16_t*)(F.ws + WS_WUQ), 256, 32 * nb, 64 * kb, 32 * nb, INP(IN_MQAG), scr, F.lane); continue; } r -= I_UQ;
        { const int kb = r / 32, nb = r % 32; transpose_item(INP(IN_WUKV), 1024, (bf16_t*)(F.ws + WS_WUKV), 256, 32 * nb, 64 * kb, 32 * nb, INP(IN_MKVAG), scr, F.lane); }
    }
}

__device__ __forceinline__ void norm_pass(Frame& F, const Params& p, int layer, const float* gain, int ch_sh, int ch_sc, bool from_inputs, bool latent_only) {
    const float* modv = (const float*)(F.ws + WS_MODV) + (size_t)layer * 17 * 6144;
    bf16_t* XN = (bf16_t*)(F.ws + WS_XN);
    const int gw = F.bid * 8 + F.wave, NGW = F.G * 8;
    for (int chunk = gw; chunk < MROWS / 18; chunk += NGW) {
        int cur = -1; f32x4 gs[4], shv[4];
        for (int r0 = 0; r0 < 18; r0 += 3) {
            f32x4 v[3][4];
#pragma unroll
            for (int q = 0; q < 3; ++q) {
                const int R = chunk * 18 + r0 + q, b = R / TU, t = R % TU; const bool isc = t < CTXL;
                const float* src;
                if (from_inputs) src = isc ? INP(IN_CTX) + ((size_t)b * CTXL + t) * 1024 : INP(IN_X) + ((size_t)b * SEQ + (t - CTXL)) * 1024;
                else src = F.out + ((size_t)b * SEQ + (isc ? 0 : t - CTXL)) * 1024;
#pragma unroll
                for (int j = 0; j < 4; ++j) v[q][j] = __builtin_nontemporal_load((const f32x4*)(src + 256 * j + 4 * F.lane));
            }
#pragma unroll
            for (int q = 0; q < 3; ++q) {
                const int R = chunk * 18 + r0 + q, b = R / TU, t = R % TU; const bool isc = t < CTXL;
                if (latent_only && isc) continue;
                const int midx = isc ? 16 : b;
                if (midx != cur) { cur = midx; const float* mv = modv + (size_t)midx * 6144;
#pragma unroll
                    for (int j = 0; j < 4; ++j) { const f32x4 g4 = *(const f32x4*)(gain + 256 * j + 4 * F.lane), sc4 = *(const f32x4*)(mv + ch_sc * 1024 + 256 * j + 4 * F.lane);
                        gs[j] = g4 * (sc4 + 1.0f); shv[j] = *(const f32x4*)(mv + ch_sh * 1024 + 256 * j + 4 * F.lane); } }
                float ss = 0.f;
#pragma unroll
                for (int j = 0; j < 4; ++j) ss += (v[q][j].x * v[q][j].x + v[q][j].y * v[q][j].y) + (v[q][j].z * v[q][j].z + v[q][j].w * v[q][j].w);
                const float rstd = 1.0f / sqrtf(wave_sum(ss) * (1.0f / 1024.0f) + EPS);
#pragma unroll
                for (int j = 0; j < 4; ++j) { const f32x4 h = v[q][j] * rstd * gs[j] + shv[j]; u32x2 w; w.x = cvtpk(h.x, h.y); w.y = cvtpk(h.z, h.w);
                    *(u32x2*)(XN + (size_t)R * 1024 + 256 * j + 4 * F.lane) = w; }
            }
        }
    }
}

__device__ __forceinline__ void shw_pass(Frame& F) {
    const float* modv = (const float*)(F.ws + WS_MODV);
    const int gw = F.bid * 8 + F.wave, NGW = F.G * 8, lane = F.lane;
    for (int it = gw; it < 5632 + 3072 + 5632; it += NGW) {
        const bf16_t* wt; const float* sh; float* dst; int n, ld;
        if (it < 5632) { n = it; wt = (const bf16_t*)(F.ws + WS_WFI); sh = modv + 3 * 1024; dst = (float*)(F.ws + WS_SHW + SHW_F0); ld = 5632; }
        else if (it < 5632 + 3072) { n = it - 5632; wt = (const bf16_t*)(F.ws + WS_WOD); sh = modv + 17 * 6144; dst = (float*)(F.ws + WS_SHW + SHW_OD); ld = 3072; }
        else { n = it - 5632 - 3072; wt = (const bf16_t*)(F.ws + WS_WFI) + (size_t)5632 * 1024; sh = modv + 17 * 6144 + 3 * 1024; dst = (float*)(F.ws + WS_SHW + SHW_F1); ld = 5632; }
        float wv[16]; { float a[8], b2[8]; unpack8(*(const u32x4*)(wt + (size_t)n * 1024 + 16 * lane), a); unpack8(*(const u32x4*)(wt + (size_t)n * 1024 + 16 * lane + 8), b2);
#pragma unroll
            for (int e = 0; e < 8; ++e) { wv[e] = a[e]; wv[8 + e] = b2[e]; } }
        float acc[17];
#pragma unroll
        for (int i = 0; i < 17; ++i) { const float* sp = sh + (size_t)i * 6144 + 16 * lane; float s2 = 0.f;
#pragma unroll
            for (int q = 0; q < 4; ++q) { const f32x4 x = *(const f32x4*)(sp + 4 * q); s2 += (x[0] * wv[4 * q] + x[1] * wv[4 * q + 1]) + (x[2] * wv[4 * q + 2] + x[3] * wv[4 * q + 3]); }
            acc[i] = s2; }
        { const bool b5 = (lane & 32) != 0, b4 = (lane & 16) != 0, b3 = (lane & 8) != 0, b2 = (lane & 4) != 0;
          float w8[8], w4[4], w2[2], z;
#pragma unroll
          for (int q = 0; q < 8; ++q) { const float snd = b5 ? acc[q] : acc[8 + q], kp = b5 ? acc[8 + q] : acc[q]; w8[q] = kp + __shfl_xor(snd, 32); }
#pragma unroll
          for (int q = 0; q < 4; ++q) { const float snd = b4 ? w8[q] : w8[4 + q], kp = b4 ? w8[4 + q] : w8[q]; w4[q] = kp + __shfl_xor(snd, 16); }
#pragma unroll
          for (int q = 0; q < 2; ++q) { const float snd = b3 ? w4[q] : w4[2 + q], kp = b3 ? w4[2 + q] : w4[q]; w2[q] = kp + __shfl_xor(snd, 8); }
          { const float snd = b2 ? w2[0] : w2[1], kp = b2 ? w2[1] : w2[0]; z = kp + __shfl_xor(snd, 4); }
          z += __shfl_xor(z, 2); z += __shfl_xor(z, 1);
          const int idx = (b5 ? 8 : 0) + (b4 ? 4 : 0) + (b3 ? 2 : 0) + (b2 ? 1 : 0);
          if ((lane & 3) == 0) dst[(size_t)idx * ld + n] = z;
          const float s16 = wave_sum(acc[16]); if (lane == 0) dst[(size_t)16 * ld + n] = s16; }
    }
}

__device__ __forceinline__ void group64_norm(float (&v)[8], const float* gain, bool rope, int prow, int pcol, const float* ropet, float oscale, int lane) {
    float ss = 0.f;
#pragma unroll
    for (int e = 0; e < 8; ++e) ss += v[e] * v[e];
    ss += __shfl_xor(ss, 1); ss += __shfl_xor(ss, 2); ss += __shfl_xor(ss, 4);
    const float rstd = 1.0f / sqrtf(ss * (1.0f / 64.0f) + EPS);
    const int u = lane & 7;
#pragma unroll
    for (int e = 0; e < 8; ++e) v[e] *= rstd * gain[8 * u + e];
    float pv[8];
#pragma unroll
    for (int e = 0; e < 8; ++e) pv[e] = __shfl_xor(v[e], 2);
    if (rope) { const int pos = (u & 4) ? pcol : prow; const float* rt = ropet + (pos * 16 + 8 * (u & 1)) * 2;
#pragma unroll
        for (int e = 0; e < 8; ++e) { const float cs = rt[2 * e], sn = rt[2 * e + 1]; v[e] = (u & 2) ? (pv[e] * sn + v[e] * cs) : (v[e] * cs - pv[e] * sn); } }
#pragma unroll
    for (int e = 0; e < 8; ++e) v[e] *= oscale;
}
__device__ __forceinline__ void post_proj0(Frame& F, const Params& p) {
    bf16_t* PROJ = (bf16_t*)(F.ws + WS_REG);
    const float* ropet = (const float*)(F.ws + WS_SMALL);
    float* rcq = (float*)(F.ws + WS_SMALL + 65536); float* rckv = (float*)(F.ws + WS_SMALL + 262144);
    const int gw = F.bid * 8 + F.wave, NGW = F.G * 8, lane = F.lane;
    for (int chunk = gw; chunk < MROWS / 18; chunk += NGW)
        for (int r = 0; r < 18; ++r) {
            const int R = chunk * 18 + r, t = R % TU; const bool lat = t >= CTXL; const int tl = lat ? t - CTXL : 0, prow = tl >> 6, pcol = tl & 63;
            bf16_t* rowp = PROJ + (size_t)R * 2048;
#pragma unroll
            for (int ci = 0; ci < 2; ++ci) { float v[8]; unpack8(*(const u32x4*)(rowp + 512 * ci + 8 * lane), v);
                group64_norm(v, ci == 0 ? INP(IN_DAQG) : INP(IN_DAKG), lat, prow, pcol, ropet, ci == 0 ? QS_DA : 1.0f, lane);
                *(u32x4*)(rowp + 512 * ci + 8 * lane) = pack8(v); }
            { float v[8]; unpack8(*(const u32x4*)(rowp + 1536 + 8 * lane), v);
              float ss = 0.f;
#pragma unroll
              for (int e = 0; e < 8; ++e) ss += v[e] * v[e];
              ss += __shfl_xor(ss, 1); ss += __shfl_xor(ss, 2); ss += __shfl_xor(ss, 4);
              const float s8 = ss; const float s16 = s8 + __shfl_xor(s8, 8); const float s32 = s16 + __shfl_xor(s16, 16);
              if (lane == 0) rcq[R] = 1.0f / sqrtf(s32 * (1.0f / 256.0f) + EPS);
              if (lane == 32) rckv[R] = 1.0f / sqrtf(s16 * (1.0f / 128.0f) + EPS);
              group64_norm(v, INP(IN_MKRG), lat, prow, pcol, ropet, 1.0f, lane);
              if (lane >= 48 && lane < 56) *(u32x4*)(rowp + 1536 + 8 * lane) = pack8(v); }
        }
}
__device__ __forceinline__ void post_up0(Frame& F, const Params& p) {
    bf16_t* KVRAW = (bf16_t*)(F.ws + WS_KVRAW);
    const int gw = F.bid * 8 + F.wave, NGW = F.G * 8, lane = F.lane, l32 = lane & 31, head = l32 >> 3, sub = l32 & 7;
    const float* g = INP(IN_MKG) + 16 * sub;
    float gn[16];
#pragma unroll
    for (int e = 0; e < 16; ++e) gn[e] = g[e];
    for (int chunk = gw; chunk < MROWS / 18; chunk += NGW)
        for (int r0 = 0; r0 < 18; r0 += 6) {
            u32x4 ra[3], rb[3];
#pragma unroll
            for (int q = 0; q < 3; ++q) { const int R = chunk * 18 + r0 + 2 * q + (lane >> 5); const bf16_t* rowp = KVRAW + (size_t)R * 1024 + 256 * head + 16 * sub;
                ra[q] = *(const u32x4*)(rowp); rb[q] = *(const u32x4*)(rowp + 8); }
#pragma unroll
            for (int q = 0; q < 3; ++q) { const int R = chunk * 18 + r0 + 2 * q + (lane >> 5); bf16_t* rowp = KVRAW + (size_t)R * 1024 + 256 * head + 16 * sub;
                float a[8], b[8]; unpack8(ra[q], a); unpack8(rb[q], b);
                float ss = 0.f;
#pragma unroll
                for (int e = 0; e < 8; ++e) ss += a[e] * a[e] + b[e] * b[e];
                ss += __shfl_xor(ss, 1); ss += __shfl_xor(ss, 2); ss += __shfl_xor(ss, 4);
                const float rn = 1.0f / sqrtf(ss * (1.0f / 128.0f) + EPS);
#pragma unroll
                for (int e = 0; e < 8; ++e) { a[e] *= rn * gn[e]; b[e] *= rn * gn[8 + e]; }
                *(u32x4*)(rowp) = pack8(a); *(u32x4*)(rowp + 8) = pack8(b); }
        }
}
__device__ __forceinline__ void post_proj1(Frame& F, const Params& p) {
    bf16_t* P1 = (bf16_t*)(F.ws + WS_REG);
    const int gw = F.bid * 8 + F.wave, NGW = F.G * 8, lane = F.lane;
    for (int chunk = gw; chunk < MROWS / 18; chunk += NGW)
        for (int r = 0; r < 18; ++r) {
            const int R = chunk * 18 + r; bf16_t* rowp = P1 + (size_t)R * ODN;
#pragma unroll
            for (int ci = 0; ci < 4; ++ci) { float v[8]; unpack8(*(const u32x4*)(rowp + 512 * ci + 8 * lane), v);
                group64_norm(v, ci < 2 ? INP(IN_NAQG) : INP(IN_NAKG), false, 0, 0, nullptr, ci < 2 ? QS_NA : 1.0f, lane);
                *(u32x4*)(rowp + 512 * ci + 8 * lane) = pack8(v); }
        }
}

#ifndef USE_TR
#define USE_TR 1
#endif
template <int MODE> struct ACfg;
template <> struct ACfg<0> { static constexpr int DQK = 192, DV = 128, NKROWS = 64; };
template <> struct ACfg<1> { static constexpr int DQK = 64, DV = 128, NKROWS = 128; };
template <> struct ACfg<2> { static constexpr int DQK = 64, DV = 64, NKROWS = 64; };
__device__ __forceinline__ int crow(int r, int hi) { return (r & 3) + 8 * (r >> 2) + 4 * hi; }
__device__ __forceinline__ bf16x8 pack8f(float a0, float a1, float a2, float a3, float a4, float a5, float a6, float a7) {
    u32x4 w; w.x = cvtpk(a0, a1); w.y = cvtpk(a2, a3); w.z = cvtpk(a4, a5); w.w = cvtpk(a6, a7); return __builtin_bit_cast(bf16x8, w); }
typedef short v4i16_t __attribute__((ext_vector_type(4)));

struct AttnArgs {
    const bf16_t* q; int q_pitch;
    const bf16_t* kA; int kA_pitch;
    const bf16_t* kB; int kB_pitch;
    const bf16_t* v; int v_pitch;
    int nt;
    int klo;
    int r0;
    const float* qg; const float* ropet; int qt0;
};

__device__ __forceinline__ void glds16(const void* gsrc, unsigned lds_dst) { unsigned keep;
    asm volatile("s_mov_b32 %0, m0\n\ts_mov_b32 m0, %2\n\ts_nop 0\n\tglobal_load_lds_dwordx4 %1, off\n\ts_mov_b32 m0, %0" : "=&s"(keep) : "v"(gsrc), "s"(lds_dst) : "memory"); }
__device__ __forceinline__ float max3f(float a, float b, float c) { float r; asm("v_max3_f32 %0, %1, %2, %3" : "=v"(r) : "v"(a), "v"(b), "v"(c)); return r; }
__device__ __forceinline__ float max2f(float a, float b) { float r; asm("v_max_f32_e32 %0, %1, %2" : "=v"(r) : "v"(a), "v"(b)); return r; }
template <int MODE, int ABL = 0, bool XS = false>
__device__ __forceinline__ void attn_core(LAS unsigned char* lds, const AttnArgs& A, f32x16 (&o)[ACfg<MODE>::DV / 32], float& linv, const LAS float* rpbl, bf16x8 (&qf)[ACfg<MODE>::DQK / 16], bool pre = false, bool has_next = false) {
    constexpr int DQK = ACfg<MODE>::DQK, DV = ACfg<MODE>::DV;
    constexpr int NIMG = (MODE == 0) ? 3 : (MODE == 1 ? 2 : 1), KBYTES = NIMG * 8192, VBYTES = 64 * DV * 2, STG = KBYTES + VBYTES, KPT = NIMG, VPT = DV / 64, PT = KPT + VPT;
    constexpr int DIST = (MODE == 2) ? 3 : 2, NSLOT = DIST + 1;
    static_assert(NSLOT * STG <= 131072, "attention tile geometry");
    const int tid = threadIdx.x, lane = tid & 63, r32 = lane & 31, hi = lane >> 5, w = __builtin_amdgcn_readfirstlane(tid >> 6);
    const int comp = (MODE == 1) ? (w >> 2) : 0, grp = (MODE == 2) ? 0 : (w >> 2);
    int qrow_idx; int rs_w = 0, rq = 0, cq = 0;
    if (MODE == 0) qrow_idx = 32 * w + r32;
    else if (MODE == 1) qrow_idx = 32 * (w & 3) + r32;
    else { rq = A.r0 + (w >> 1); cq = 32 * (w & 1) + r32; qrow_idx = (w >> 1) * 64 + cq; rs_w = rq - 4 < 0 ? 0 : (rq - 4 > 24 ? 24 : rq - 4); }
    const bf16_t* qrow = A.q + (size_t)qrow_idx * A.q_pitch + (MODE == 1 ? 64 * comp : 0);
#pragma unroll
    for (int d = 0; d < DV / 32; ++d) o[d] = (f32x16){0.f, 0.f, 0.f, 0.f, 0.f, 0.f, 0.f, 0.f, 0.f, 0.f, 0.f, 0.f, 0.f, 0.f, 0.f, 0.f};
    float lsum = 0.f;
    const int cs_q = (MODE == 2) ? (cq - 8 < 0 ? 0 : (cq - 8 > 48 ? 48 : cq - 8)) : 0;
    unsigned vm0 = 0u, vm1 = 0u;
    if (MODE == 2) {
#pragma unroll
        for (int r = 0; r < 16; ++r) { const int kc = crow(r, hi); vm0 |= ((unsigned)(kc - cs_q) < 16u ? 1u : 0u) << r; vm1 |= ((unsigned)(kc + 32 - cs_q) < 16u ? 1u : 0u) << r; } }
    unsigned koff[KPT], voff[VPT];
    { const int row = 8 * w + (lane >> 3), sc = (lane & 7) ^ ((row >> 1) & 7);
#pragma unroll
      for (int i = 0; i < KPT; ++i) {
        if (MODE == 0) koff[i] = (i < 2) ? (unsigned)(row * A.kA_pitch + 64 * i + sc * 8) * 2u : (unsigned)(row * A.kB_pitch + sc * 8) * 2u;
        else koff[i] = (unsigned)(row * A.kA_pitch + sc * 8) * 2u;
      } }
#pragma unroll
    for (int i = 0; i < VPT; ++i) { const int pc = w + 8 * i, dblk = pc >> 2, rg = pc & 3; voff[i] = (unsigned)((16 * rg + (lane >> 2)) * A.v_pitch + 32 * dblk + (lane & 3) * 8) * 2u; }
#define TILE_T0(tile) ((MODE == 2) ? ((tile) < 4 ? 64 * (tile) : CTXL + 64 * (A.klo + (tile) - 4)) : 64 * (tile))
#define DMA_TILE(tile, slotoff) do { const int t0_ = TILE_T0(tile); \
        const char* kAb_ = (const char*)A.kA + (size_t)t0_ * A.kA_pitch * 2; const char* kBb_ = (const char*)A.kB + (size_t)t0_ * A.kB_pitch * 2; const char* vb_ = (const char*)A.v + (size_t)t0_ * A.v_pitch * 2; \
        _Pragma("unroll") for (int i = 0; i < KPT; ++i) { const char* b_ = (MODE == 0) ? (i < 2 ? kAb_ : kBb_) : ((MODE == 1 && i == 1) ? kBb_ : kAb_); \
            glds16(b_ + koff[i], (unsigned)__builtin_amdgcn_readfirstlane((int)(lds0 + (unsigned)((slotoff) + i * 8192 + w * 1024)))); } \
        _Pragma("unroll") for (int i = 0; i < VPT; ++i) \
            glds16(vb_ + voff[i], (unsigned)__builtin_amdgcn_readfirstlane((int)(lds0 + (unsigned)((slotoff) + KBYTES + (w + 8 * i) * 1024)))); } while (0)
#define WAITV(n) asm volatile("s_waitcnt vmcnt(" #n ")" ::: "memory")
#define WAIT_TILE(more) do { if (more) { if (PT == 2) WAITV(2); else if (PT == 4) WAITV(4); else WAITV(5); } else WAITV(0); } while (0)
#define WAIT_TILE2(newer) do { if ((newer) >= 2) { if (PT == 2) WAITV(4); else if (PT == 4) WAITV(8); else WAITV(10); } else WAIT_TILE((newer) >= 1); } while (0)
#define BAR() do { __builtin_amdgcn_s_barrier(); asm volatile("" ::: "memory"); } while (0)
    const unsigned lds0 = (unsigned)(uintptr_t)lds;
    int s_cur = 0, s_n1 = STG, s_n2 = 2 * STG, s_n3 = 3 * STG;
    if (XS && pre) { WAITV(8);
#pragma unroll
        for (int s = 0; s < DQK / 16; ++s) asm volatile("" : "+v"(qf[s]));
    } else {
    DMA_TILE(0, 0);
    if (A.nt > 1) DMA_TILE(1, STG);
    if (DIST > 2 && A.nt > 2) DMA_TILE(2, 2 * STG);
#pragma unroll
    for (int s = 0; s < DQK / 16; ++s) qf[s] = *(const bf16x8*)(qrow + 16 * s + 8 * hi);
    WAITV(0);
#pragma unroll
    for (int s = 0; s < DQK / 16; ++s) asm volatile("" : "+v"(qf[s]));
    }
#pragma unroll
    for (int s = 0; s < DQK / 16; ++s) asm volatile("" : "+v"(qf[s]));
    if (MODE == 0) {
        float ss = 0.f;
#pragma unroll
        for (int s = 0; s < DQK / 16; ++s) { float v[8]; unpack8(__builtin_bit_cast(u32x4, qf[s]), v);
#pragma unroll
            for (int j = 0; j < 8; ++j) ss += v[j] * v[j]; }
        ss = pg8::sum_xor32(ss);
        const float rn = QS_MLA / sqrtf(ss * (1.0f / 192.0f) + EPS);
        const int tq = A.qt0 + qrow_idx; const bool lat = tq >= CTXL; const int tl = lat ? tq - CTXL : 0;
#pragma unroll
        for (int s = 0; s < 8; ++s) { float v[8]; unpack8(__builtin_bit_cast(u32x4, qf[s]), v);
            const f32x4 g0 = *(const f32x4*)(A.qg + 16 * s + 8 * hi), g1 = *(const f32x4*)(A.qg + 16 * s + 8 * hi + 4);
            v[0] *= rn * g0[0]; v[1] *= rn * g0[1]; v[2] *= rn * g0[2]; v[3] *= rn * g0[3]; v[4] *= rn * g1[0]; v[5] *= rn * g1[1]; v[6] *= rn * g1[2]; v[7] *= rn * g1[3];
            qf[s] = __builtin_bit_cast(bf16x8, pack8(v)); asm volatile("" : "+v"(qf[s])); }
#pragma unroll
        for (int h2 = 0; h2 < 2; ++h2) {
            float x1[8], x2[8]; unpack8(__builtin_bit_cast(u32x4, qf[8 + 2 * h2]), x1); unpack8(__builtin_bit_cast(u32x4, qf[9 + 2 * h2]), x2);
            const float* ga = A.qg + 16 * (8 + 2 * h2) + 8 * hi; const float* gb = ga + 16;
            const float* rt = A.ropet + (((h2 == 0) ? (tl >> 6) : (tl & 63)) * 16 + 8 * hi) * 2;
#pragma unroll
            for (int j = 0; j < 8; ++j) { const float a1 = x1[j] * rn * ga[j], a2 = x2[j] * rn * gb[j]; const float cs = lat ? rt[2 * j] : 1.0f, sn = lat ? rt[2 * j + 1] : 0.0f;
                x1[j] = a1 * cs - a2 * sn; x2[j] = a1 * sn + a2 * cs; }
            qf[8 + 2 * h2] = __builtin_bit_cast(bf16x8, pack8(x1)); qf[9 + 2 * h2] = __builtin_bit_cast(bf16x8, pack8(x2));
            asm volatile("" : "+v"(qf[8 + 2 * h2]), "+v"(qf[9 + 2 * h2])); }
    }
    if (grp == 1) { WAIT_TILE(A.nt > 1); BAR(); }
    const int vlane = ((lane >> 4) & 1) * 32 + (lane & 3) * 8 + (4 * hi + ((lane & 15) >> 2)) * 64;
    int kx[4];
#pragma unroll
    for (int q = 0; q < 4; ++q) kx[q] = r32 * 128 + (((2 * q + hi) ^ ((r32 >> 1) & 7)) << 4);
#pragma nounroll
    for (int t = 0; t < A.nt; ++t) {
        if (grp == 0) { if (DIST == 3) WAIT_TILE2(A.nt - 1 - t); else WAIT_TILE(t + 1 < A.nt); }
        BAR();
        if (MODE == 2) { if (t + DIST < A.nt) DMA_TILE(t + DIST, s_n3); } else if (grp == 1 && t + 2 < A.nt) DMA_TILE(t + 2, s_n2);
        bool active = true; int kr = 0; const bool namask = (MODE == 2) && (t >= 4);
        if (MODE == 2 && t >= 4) { kr = A.klo + t - 4; active = (kr >= rs_w) && (kr <= rs_w + 7); }
        if (ABL == 1) active = false;
        const LAS unsigned char* kb = lds + s_cur + (MODE == 1 ? comp * 8192 : 0);
        const LAS unsigned char* vb = lds + s_cur + KBYTES + vlane;
        f32x16 p0 = (f32x16){0.f, 0.f, 0.f, 0.f, 0.f, 0.f, 0.f, 0.f, 0.f, 0.f, 0.f, 0.f, 0.f, 0.f, 0.f, 0.f}, p1 = p0;
        if (MODE == 2) {
            const LAS float* bl = rpbl + ((t >= 4) ? (kr - rq + 7) : 15) * 128 + (4 * hi - cq + 63);
#pragma unroll
            for (int r = 0; r < 16; ++r) { p0[r] = bl[(r & 3) + 8 * (r >> 2)]; p1[r] = bl[32 + (r & 3) + 8 * (r >> 2)]; }
        }
        bf16x8 pf[4];
        v4i16_t va[8], vb2[8];
#define SB() __builtin_amdgcn_sched_barrier(0)
#define KFRAG(s_, half_) (*(const LAS bf16x8*)(kb + ((s_) >> 2) * 8192 + kx[(s_) & 3] + (half_) * 4096))
#define KREAD(dst, b) do { dst[0] = KFRAG(2 * (b), 0); dst[1] = KFRAG(2 * (b), 1); dst[2] = KFRAG(2 * (b) + 1, 0); dst[3] = KFRAG(2 * (b) + 1, 1); } while (0)
#define KMMA(src, b) do { p0 = __builtin_amdgcn_mfma_f32_32x32x16_bf16(src[0], qf[2 * (b)], p0, 0, 0, 0); p1 = __builtin_amdgcn_mfma_f32_32x32x16_bf16(src[1], qf[2 * (b)], p1, 0, 0, 0); \
                          p0 = __builtin_amdgcn_mfma_f32_32x32x16_bf16(src[2], qf[2 * (b) + 1], p0, 0, 0, 0); p1 = __builtin_amdgcn_mfma_f32_32x32x16_bf16(src[3], qf[2 * (b) + 1], p1, 0, 0, 0); } while (0)
#define VREAD(dst, d) do { _Pragma("unroll") for (int ks_ = 0; ks_ < 4; ++ks_) { dst[2 * ks_] = __builtin_amdgcn_ds_read_tr16_b64_v4i16((LAS v4i16_t*)(vb + (d) * 4096 + ks_ * 1024)); \
                                                                             dst[2 * ks_ + 1] = __builtin_amdgcn_ds_read_tr16_b64_v4i16((LAS v4i16_t*)(vb + (d) * 4096 + ks_ * 1024 + 512)); } } while (0)
#define VMMA(src, d) do { _Pragma("unroll") for (int ks_ = 0; ks_ < 4; ++ks_) { const bf16x8 vf_ = (bf16x8){src[2 * ks_][0], src[2 * ks_][1], src[2 * ks_][2], src[2 * ks_][3], src[2 * ks_ + 1][0], src[2 * ks_ + 1][1], src[2 * ks_ + 1][2], src[2 * ks_ + 1][3]}; \
                              o[d] = __builtin_amdgcn_mfma_f32_32x32x16_bf16(vf_, pf[ks_], o[d], 0, 0, 0); } } while (0)
        if (active) {
            bf16x8 fa[4], fb[4];
            constexpr int NB = DQK / 32;
            KREAD(fa, 0);
#pragma unroll
            for (int b = 0; b < NB; b += 2) {
                KREAD(fb, b + 1); SB(); KMMA(fa, b); SB();
                if (b + 2 < NB) KREAD(fa, b + 2);
                SB(); KMMA(fb, b + 1); SB();
            }
            if (ABL == 3) { asm volatile("" :: "v"(p0), "v"(p1)); } else {
            SB();
            float rsum = 0.f;
#define EXPPACK(ks_, P, base) do { float e_[8]; _Pragma("unroll") for (int j_ = 0; j_ < 8; ++j_) { e_[j_] = __builtin_amdgcn_exp2f(P[(base) + j_]); \
                    if (MODE == 2 && namask) e_[j_] = __uint_as_float(__float_as_uint(e_[j_]) & (unsigned)__builtin_amdgcn_sbfe((int)((ks_) < 2 ? vm0 : vm1), (base) + j_, 1)); } \
                rsum += ((e_[0] + e_[1]) + (e_[2] + e_[3])) + ((e_[4] + e_[5]) + (e_[6] + e_[7])); pf[ks_] = pack8f(e_[0], e_[1], e_[2], e_[3], e_[4], e_[5], e_[6], e_[7]); SB(); } while (0)
            EXPPACK(0, p0, 0); EXPPACK(1, p0, 8); EXPPACK(2, p1, 0); EXPPACK(3, p1, 8);
#undef EXPPACK
            lsum += rsum;
            }
        }
        if (grp == 1 && t + 1 < A.nt) WAIT_TILE(t + 2 < A.nt);
        if (MODE != 2) BAR();
        if (MODE != 2 && grp == 0 && t + 2 < A.nt) DMA_TILE(t + 2, s_n2);
        if (active && ABL != 3) {
            if (ABL == 2) { asm volatile("" :: "v"(pf[0]), "v"(pf[1]), "v"(pf[2]), "v"(pf[3])); } else {
            constexpr int ND = DV / 32;
            VREAD(va, 0);
#pragma unroll
            for (int d = 0; d < ND; d += 2) {
                VREAD(vb2, d + 1); SB(); VMMA(va, d); SB();
                if (d + 2 < ND) VREAD(va, d + 2);
                SB(); VMMA(vb2, d + 1); SB();
            }
            }
        }
#undef SB
#undef KFRAG
#undef KREAD
#undef KMMA
#undef VREAD
#undef VMMA
        if (NSLOT == 4) { const int tmp = s_cur; s_cur = s_n1; s_n1 = s_n2; s_n2 = s_n3; s_n3 = tmp; } else { const int tmp = s_cur; s_cur = s_n1; s_n1 = s_n2; s_n2 = tmp; }
    }
    if (MODE != 2 && grp == 0) BAR();
    BAR();
    if (XS && has_next) {
        DMA_TILE(0, 0); DMA_TILE(1, STG); DMA_TILE(2, 2 * STG);
        const bf16_t* qn = qrow + (size_t)256 * A.q_pitch;
#pragma unroll
        for (int s = 0; s < DQK / 16; ++s) qf[s] = *(const bf16x8*)(qn + 16 * s + 8 * hi);
    }
    const float l = pg8::sum_xor32(lsum);
    linv = 1.0f / l;
#undef TILE_T0
#undef DMA_TILE
#undef WAITV
#undef WAIT_TILE
#undef WAIT_TILE2
#undef BAR
}

template <int NDV>
__device__ __forceinline__ void store_o(const f32x16 (&o)[NDV], float sc, bf16_t* orow, int hi) {
#pragma unroll
    for (int d = 0; d < NDV; ++d)
#pragma unroll
        for (int g = 0; g < 4; ++g) { u32x2 wv; wv.x = cvtpk(o[d][4 * g] * sc, o[d][4 * g + 1] * sc); wv.y = cvtpk(o[d][4 * g + 2] * sc, o[d][4 * g + 3] * sc);
            *(u32x2*)(orow + 32 * d + 8 * g + 4 * hi) = wv; }
}

constexpr int DA_XBUF = 0;
constexpr int NA_RPB = 4 * (8192 + 8192);

template <int ABL = 0>
__device__ __forceinline__ void mla_unit(Frame& F, const Params& p, int b, int h, int qb) {
    const bf16_t* PROJ = (const bf16_t*)(F.ws + WS_REG); const bf16_t* QRAW = (const bf16_t*)(F.ws + WS_QRAW); const bf16_t* KVRAW = (const bf16_t*)(F.ws + WS_KVRAW);
    bf16_t* Y = (bf16_t*)(F.ws + WS_Y);
    const size_t R0 = (size_t)b * TU;
    AttnArgs A; A.q = QRAW + (R0 + 256 * qb) * 768 + 192 * h; A.q_pitch = 768;
    A.kA = KVRAW + R0 * 1024 + 256 * h; A.kA_pitch = 1024; A.kB = PROJ + R0 * 2048 + 1920; A.kB_pitch = 2048;
    A.v = KVRAW + R0 * 1024 + 256 * h + 128; A.v_pitch = 1024; A.nt = (qb == 0) ? 4 : 36; A.klo = 0; A.r0 = 0; A.qg = INP(IN_MQG); A.ropet = (const float*)(F.ws + WS_SMALL); A.qt0 = 256 * qb;
    f32x16 o[4]; float linv; bf16x8 qf[12];
    attn_core<0, ABL>(F.lds, A, o, linv, nullptr, qf);
    int lane_ = F.lane; asm volatile("" : "+v"(lane_));
    const int r32 = lane_ & 31, hi = lane_ >> 5;
    store_o<4>(o, linv, Y + (R0 + 256 * qb + 32 * F.wave + r32) * 1024 + 512 + 128 * h, hi);
}
template <int ABL = 0>
__device__ __forceinline__ void da_unit(Frame& F, const Params& p, int b, int h, int qb, float lam) {
    const bf16_t* PROJ = (const bf16_t*)(F.ws + WS_REG); bf16_t* Y = (bf16_t*)(F.ws + WS_Y);
    const size_t R0 = (size_t)b * TU;
    AttnArgs A; A.q = PROJ + (R0 + 128 * qb) * 2048 + 128 * h; A.q_pitch = 2048;
    A.kA = PROJ + R0 * 2048 + 512 + 128 * h; A.kA_pitch = 2048; A.kB = A.kA + 64; A.kB_pitch = 2048;
    A.v = PROJ + R0 * 2048 + 1024 + 128 * h; A.v_pitch = 2048; A.nt = (qb < 2) ? 4 : 36; A.klo = 0; A.r0 = 0; A.qg = nullptr; A.ropet = nullptr; A.qt0 = 0;
    f32x16 o[4]; float linv; bf16x8 qf[4];
    attn_core<1, ABL>(F.lds, A, o, linv, nullptr, qf);
    int lane_ = F.lane; asm volatile("" : "+v"(lane_));
    const int r32 = lane_ & 31, hi = lane_ >> 5, comp = F.wave >> 2;
    LAS float* xb = (LAS float*)(F.lds + DA_XBUF) + (F.wave & 3) * 4096;
    if (comp == 1) {
#pragma unroll
        for (int d = 0; d < 4; ++d)
#pragma unroll
            for (int r = 0; r < 16; ++r) xb[(d * 16 + r) * 64 + lane_] = o[d][r] * linv; }
    __syncthreads();
    if (comp == 0) {
        float ss = 0.f;
#pragma unroll
        for (int d = 0; d < 4; ++d) {
#pragma unroll
            for (int r = 0; r < 16; ++r) { const float v = o[d][r] * linv - lam * xb[(d * 16 + r) * 64 + lane_]; o[d][r] = v; ss += v * v; }
            __builtin_amdgcn_sched_barrier(0); }
        ss += __shfl_xor(ss, 32);
        const float sc = (1.0f - LAM_INIT0) / sqrtf(ss * (1.0f / 128.0f) + EPS);
        const float* og = INP(IN_DAOG);
#pragma unroll
        for (int d = 0; d < 4; ++d)
#pragma unroll
            for (int g = 0; g < 4; ++g) { const f32x4 gv = *(const f32x4*)(og + 32 * d + 8 * g + 4 * hi);
                o[d][4 * g] *= gv.x; o[d][4 * g + 1] *= gv.y; o[d][4 * g + 2] *= gv.z; o[d][4 * g + 3] *= gv.w; }
        store_o<4>(o, sc, Y + (R0 + 128 * qb + 32 * (F.wave & 3) + r32) * 1024 + 128 * h, hi);
    }
    __syncthreads();
}
template <int ABL = 0>
__device__ __forceinline__ void na_unit(Frame& F, const Params& p, int b, int h, int band, bf16x8 (&qf)[4]) {
    const bf16_t* P1 = (const bf16_t*)(F.ws + WS_REG); bf16_t* Y = (bf16_t*)(F.ws + WS_Y);
    const size_t R0 = (size_t)b * TU;
    const int r0 = 4 * band; const int klo = r0 - 4 < 0 ? 0 : (r0 - 4 > 24 ? 24 : r0 - 4); const int rs3 = r0 - 1 < 0 ? 0 : (r0 - 1 > 24 ? 24 : r0 - 1); const int khi = rs3 + 7;
    AttnArgs A; A.q = P1 + (R0 + CTXL + 64 * r0) * ODN + 64 * h; A.q_pitch = ODN;
    A.kA = P1 + R0 * ODN + 1024 + 64 * h; A.kA_pitch = ODN; A.kB = A.kA; A.kB_pitch = ODN;
    A.v = P1 + R0 * ODN + 2048 + 64 * h; A.v_pitch = ODN; A.nt = 4 + (khi - klo + 1); A.klo = klo; A.r0 = r0; A.qg = nullptr; A.ropet = nullptr; A.qt0 = 0;
    f32x16 o[2]; float linv;
    attn_core<2, ABL, true>(F.lds, A, o, linv, (const LAS float*)(F.lds + NA_RPB), qf, band > 0, band < 7);
    int lane_ = F.lane; asm volatile("" : "+v"(lane_));
    const int r32 = lane_ & 31, hi = lane_ >> 5;
    store_o<2>(o, linv, Y + (R0 + CTXL + 64 * (r0 + (F.wave >> 1)) + 32 * (F.wave & 1) + r32) * 1024 + 64 * h, hi);
}


#define RLX_AGENT __ATOMIC_RELAXED, __HIP_MEMORY_SCOPE_AGENT
#define XB_TMO      128
#define XB_XCNT(j)  (256  + 64 * (j))
#define XB_XSUB(j)  (1280 + 64 * (j))
#define XB_XGEN(j)  (2304 + 64 * (j))
#define XB_TOP      3328
#define XB_TOPGEN   3392
#define XCD_BAR_WORDS 3456
#define XB_SPIN_CAP (1u << 18)

__device__ __forceinline__ unsigned xb_ld(unsigned* p)              { return __hip_atomic_load(p, __ATOMIC_RELAXED, __HIP_MEMORY_SCOPE_AGENT); }
__device__ __forceinline__ unsigned xb_add(unsigned* p, unsigned v) { return __hip_atomic_fetch_add(p, v, __ATOMIC_RELAXED, __HIP_MEMORY_SCOPE_AGENT); }
__device__ __forceinline__ unsigned xb_xcc_id() { return (unsigned)__builtin_amdgcn_s_getreg((3 << 11) | 20) & 0xFu; }
#define XB_SPIN(cond, bar) do { unsigned _sp = 0; while (cond) { __builtin_amdgcn_s_sleep(1); \
    if ((++_sp & 255u) == 0u) { if (xb_ld(&(bar)[XB_TMO])) break; if (_sp > XB_SPIN_CAP) { atomicAdd(&(bar)[XB_TMO], 1u); break; } } } } while (0)

struct XcdBarrier {
    unsigned* bar; unsigned x;
    volatile LAS unsigned* st;
};

__device__ __forceinline__ XcdBarrier xcd_barrier_post(unsigned* bar, volatile LAS unsigned* st) {
    XcdBarrier b; b.bar = bar; b.x = xb_xcc_id(); b.st = st;
    if (threadIdx.x == 0) (void)xb_add(&bar[XB_XCNT(b.x)], 1u);
    return b;
}
__device__ __forceinline__ void xcd_barrier_complete(unsigned* bar, unsigned x, unsigned& nloc, unsigned& nx) {
    const unsigned G = gridDim.x * gridDim.y * gridDim.z;
    unsigned sum, cnt, mine, sp = 0u;
    for (;;) {
        sum = 0u; cnt = 0u; mine = 0u;
#pragma unroll
        for (unsigned j = 0; j < 16; ++j) { const unsigned c = xb_ld(&bar[XB_XCNT(j)]); sum += c; cnt += (c > 0u) ? 1u : 0u; mine = (j == x) ? c : mine; }
        if (sum == G) break;
        __builtin_amdgcn_s_sleep(1);
        if ((++sp & 255u) == 0u) { if (xb_ld(&bar[XB_TMO])) break; if (sp > XB_SPIN_CAP) { atomicAdd(&bar[XB_TMO], 1u); break; } }
    }
    nloc = mine > 0u ? mine : 1u; nx = cnt > 0u ? cnt : 1u;
}

__device__ __forceinline__ void xcd_barrier(const XcdBarrier& b) {
    asm volatile("s_waitcnt vmcnt(0)" ::: "memory");
    __syncthreads();
    if (threadIdx.x == 0) {
        unsigned* bar = b.bar;
        __builtin_amdgcn_s_waitcnt(0);
        unsigned nloc = b.st[0], nx = b.st[1];
        if (nloc == 0u) { xcd_barrier_complete(bar, b.x, nloc, nx); b.st[0] = nloc; b.st[1] = nx; }
        const unsigned old = xb_add(&bar[XB_XSUB(b.x)], 1u);
        const unsigned gen = old / nloc;
        if (old + 1u == (gen + 1u) * nloc) {
            __builtin_amdgcn_fence(__ATOMIC_RELEASE, "agent");
            asm volatile("s_waitcnt vmcnt(0)" ::: "memory");
            const unsigned og = xb_add(&bar[XB_TOP], 1u);
            const unsigned tg = og / nx;
            if (og + 1u == (tg + 1u) * nx) xb_add(&bar[XB_TOPGEN], 1u);
            else XB_SPIN(xb_ld(&bar[XB_TOPGEN]) == tg, bar);
            __builtin_amdgcn_fence(__ATOMIC_ACQUIRE, "agent");
            xb_add(&bar[XB_XGEN(b.x)], 1u);
            asm volatile("s_waitcnt vmcnt(0)" ::: "memory");
        } else {
            XB_SPIN(xb_ld(&bar[XB_XGEN(b.x)]) == gen, bar);
            __builtin_amdgcn_fence(__ATOMIC_ACQUIRE, "agent");
            asm volatile("s_waitcnt vmcnt(0)" ::: "memory");
        }
    }
    __syncthreads();
}

__device__ __forceinline__ void zero_state(Frame& F) {
    if (F.bid == 0) { unsigned* bar = (unsigned*)(F.ws + WS_CTL) + 4096; for (int i = F.tid; i < XCD_BAR_WORDS; i += 512) __hip_atomic_store(bar + i, 0u, __ATOMIC_RELAXED, __HIP_MEMORY_SCOPE_AGENT); }
    const pg8::u32x4 z = {0u, 0u, 0u, 0u};
    for (int e = F.bid * 512 + F.tid; e < 1024 * 16; e += F.G * 512) { const int row = e >> 4, c = e & 15; *(pg8::u32x4*)(F.ws + WS_WUKV + (size_t)row * 512 + 256 + c * 16) = z; }
    for (int e = F.bid * 512 + F.tid; e < 64 * 128; e += F.G * 512) { const int rr = e >> 7, c = e & 127; const int row = (rr < 32 ? 1888 : 1984) + rr; *(pg8::u32x4*)(F.ws + WS_WEV + (size_t)row * 2048 + c * 16) = z; }
}

constexpr int N_PHASES = 15;
__global__ void __launch_bounds__(512, 2) fwd_kernel(Params p) {
    extern __shared__ __attribute__((aligned(16))) unsigned char lds_raw[];
    Frame F;
    F.lds = (LAS unsigned char*)lds_raw;
    F.tid = threadIdx.x; F.lane = F.tid & 63; F.wave = __builtin_amdgcn_readfirstlane(F.tid >> 6); F.G = gridDim.x; F.bid = blockIdx.x;
    F.out = p.out; F.ws = p.ws; F.abl = p.abl;
    cg::grid_group grid = cg::this_grid();
    const int lo = p.ph_lo, hi_ = p.ph_hi;
    volatile LAS unsigned* xbst = (volatile LAS unsigned*)(F.lds + LDS_BYTES - 64);
    if (F.tid < 2) xbst[F.tid] = 0u;
    __syncthreads();
    XcdBarrier xbar; xbar.bar = (unsigned*)(F.ws + WS_CTL) + 4096; xbar.x = xb_xcc_id(); xbar.st = xbst;
    if (lo > 0 && F.tid == 0) (void)xb_add(&xbar.bar[XB_XCNT(xbar.x)], 1u);
#ifndef PH_MASK
#define PH_MASK 0x7fff
#endif
#define PH(k) (((PH_MASK >> (k)) & 1) && lo <= (k) && (k) < hi_)
#ifndef USE_XB
#define USE_XB 1
#endif
#define SEAM(k) do { if (PH(k) && PH((k) + 1)) { if (!USE_XB || (k) == 0) grid.sync(); else xcd_barrier(xbar); } } while (0)
    bf16_t* const XN = (bf16_t*)(F.ws + WS_XN); bf16_t* const Y = (bf16_t*)(F.ws + WS_Y);
    bf16_t* const REG = (bf16_t*)(F.ws + WS_REG);
    bf16_t* const XR16 = (bf16_t*)(F.ws + WS_XR16);
    const float* const modv = (const float*)(F.ws + WS_MODV);
    using pg8::Gemm; using pg8::StaticOrder; using pg8::LatentOrder; using pg8::EpiStore; using pg8::EpiRes; using pg8::EpiSwiGLU;

    const float* const ropet = (const float*)(F.ws + WS_SMALL);
#define SSQP(slot, k) ((float*)(F.ws + WS_SSQ + (size_t)((F.abl && (k) == hi_ - 1) ? 5 : (slot)) * SSQ_STRIDE))
    if (PH(0)) { p0_prologue(F, p); zero_state(F); }
    SEAM(0);
    if (lo == 0 && F.tid == 0) (void)xb_add(&xbar.bar[XB_XCNT(xbar.x)], 1u);
    if (PH(1)) { norm_pass(F, p, 0, INP(IN_NMIX), 0, 1, true, false); shw_pass(F); }
    SEAM(1);
    if (PH(2)) { Gemm g{XN, (const bf16_t*)(F.ws + WS_WEV), MROWS, EVNP, 1024, 1024}; StaticOrder S; S.init(MROWS, EVNP, F.G, F.bid);
        const float* gq = INP(IN_DAQG); const float* gk = INP(IN_DAKG); const float* gr = INP(IN_MKRG); float* const sq_cq = SSQP(0, 2); float* const sq_ckv = SSQP(1, 2);
        auto gf = [=](int g) -> pg8::ProjGroup { if (g < 8) return {1, gq, QS_DA, 1, nullptr}; if (g < 16) return {1, gk, 1.0f, 1, nullptr}; if (g < 24) return {0, nullptr, 1.0f, 0, nullptr};
            if (g < 28) return {2, nullptr, 1.0f, 0, sq_cq}; if (g < 30) return {2, nullptr, 1.0f, 0, sq_ckv}; if (g == 30) return {1, gr, 1.0f, 1, nullptr}; return {0, nullptr, 1.0f, 0, nullptr}; };
        pg8::EpiProj<false, decltype(gf)> E{REG, 2048, nullptr, nullptr, 0, ropet, gf};
        pg8::gemm_phase<pg8::EpiProj<false, decltype(gf)>, StaticOrder, true, true>(F.lds, g, S, E); }
    SEAM(2);
    if (PH(3)) {
        int kup = 256; asm volatile("" : "+s"(kup));
        Gemm g{REG, (const bf16_t*)(F.ws + WS_WUQ), MROWS, 1792, kup, 2048}; pg8::UpOrder S; S.init(MROWS, 1792, F.G, F.bid);
        pg8::EpiUp E{(bf16_t*)(F.ws + WS_QRAW), (bf16_t*)(F.ws + WS_KVRAW), (const float*)(F.ws + WS_SSQ), (const float*)(F.ws + WS_SSQ + SSQ_STRIDE)};
        pg8::gemm_phase<pg8::EpiUp, pg8::UpOrder, true, true>(F.lds, g, S, E);
    }
    SEAM(3);
    if (PH(4)) post_up0(F, p);
    SEAM(4);
    if (PH(5)) {
        float lam; { const float a = INP(IN_LQ1)[F.lane] * INP(IN_LK1)[F.lane], b2 = INP(IN_LQ2)[F.lane] * INP(IN_LK2)[F.lane]; lam = __expf(wave_sum(a)) - __expf(wave_sum(b2)) + LAM_INIT0; }
        const int xcd = F.bid & 7, slot = F.bid >> 3;
        if (F.G == 256) {
            for (int i = 0; i < 2; ++i) { const int g = xcd * 8 + 4 * i + (slot >> 3), qb = 1 + (slot & 7); mla_unit<0>(F, p, g >> 2, g & 3, qb); }
            for (int i = 0; i < 4; ++i) { const int g = xcd * 8 + 2 * i + (slot >> 4), qb = 2 + (slot & 15); da_unit<0>(F, p, g >> 2, g & 3, qb, lam); }
            if (F.bid < 128) { const int g = F.bid >> 1; da_unit<0>(F, p, g >> 2, g & 3, F.bid & 1, lam); }
            else if (F.bid < 192) { const int g = F.bid - 128; mla_unit<0>(F, p, g >> 2, g & 3, 0); }
        } else {
            for (int u = F.bid; u < 64 * 9; u += F.G) { const int g = u / 9, qb = u % 9; mla_unit<0>(F, p, g >> 2, g & 3, qb); }
            for (int u = F.bid; u < 64 * 18; u += F.G) { const int g = u / 18, qb = u % 18; da_unit<0>(F, p, g >> 2, g & 3, qb, lam); }
        }
    }
    SEAM(5);
    const int slot32 = F.bid >> 3, pos_of = slot32 >= 8 ? slot32 - 8 : 24 + slot32;
    if (PH(6)) { Gemm g{Y, (const bf16_t*)(F.ws + WS_WO), MROWS, 1024, 1024, 1024}; LatentOrder S; S.init(1024, F.G, F.bid);
        pg8::EpiRes3<true, false> E{INP(IN_X), INP(IN_CTX), XR16, F.out, modv, 2, XN, SSQP(2, 6), INP(IN_NFFN), modv, 4};
        pg8::gemm_phase<pg8::EpiRes3<true, false>, LatentOrder, true, true>(F.lds, g, S, E); }
    SEAM(6);
    if (PH(7)) {
        { Gemm g{Y, (const bf16_t*)(F.ws + WS_WO), MROWS, 1024, 1024, 1024}; pg8::XcdOrder S; S.init(F.bid, 1, 4, 0, slot32, 1, 8, 0, 8, 0);
          pg8::EpiRes3<true, false> E{INP(IN_X), INP(IN_CTX), XR16, F.out, modv, 2, XN, SSQP(2, 7), INP(IN_NFFN), modv, 4};
          pg8::gemm_phase<pg8::EpiRes3<true, false>, pg8::XcdOrder, true, true>(F.lds, g, S, E); }
        { Gemm g{XN, (const bf16_t*)(F.ws + WS_WFI), MROWS, 2 * DFF, 1024, 1024}; pg8::XcdOrder S; S.init(F.bid, 0, 22, 0, pos_of, 12, 8, 11, 24, 10);
          pg8::EpiSwiGLU2 E{REG, (const float*)(F.ws + WS_SSQ + 2 * SSQ_STRIDE), (const float*)(F.ws + WS_SHW + SHW_F0)};
          pg8::gemm_phase<pg8::EpiSwiGLU2, pg8::XcdOrder, true, true>(F.lds, g, S, E); }
    }
    SEAM(7);
    if (PH(8)) {
        { Gemm g{REG, (const bf16_t*)(F.ws + WS_WFO), MROWS, 1024, DFF, HIDP}; pg8::XcdOrder S; S.init(F.bid, 0, 4, 0, slot32, 2, 32, 2, 32, 2);
          pg8::EpiRes3<false, false> E{nullptr, nullptr, XR16, F.out, modv, 5, XN, SSQP(3, 8), INP(IN_NMIX) + 1024, modv + 17 * 6144, 1};
          pg8::gemm_phase<pg8::EpiRes3<false, false>, pg8::XcdOrder, true, true>(F.lds, g, S, E); }
        { Gemm g{XN, (const bf16_t*)(F.ws + WS_WFI), MROWS, 2 * DFF, 1024, 1024}; pg8::XcdOrder S; S.init(F.bid, 1, 22, 0, slot32, 2, 12, 1, 32, 1);
          pg8::EpiSwiGLU2 E{REG, (const float*)(F.ws + WS_SSQ + 2 * SSQ_STRIDE), (const float*)(F.ws + WS_SHW + SHW_F0)};
          pg8::gemm_phase<pg8::EpiSwiGLU2, pg8::XcdOrder, true, true>(F.lds, g, S, E); }
    }
    SEAM(8);
    if (PH(9)) {
        { Gemm g{REG, (const bf16_t*)(F.ws + WS_WFO), MROWS, 1024, DFF, HIDP}; pg8::XcdOrder S; S.init(F.bid, 1, 4, 0, slot32, 1, 8, 0, 8, 0);
          pg8::EpiRes3<false, false> E{nullptr, nullptr, XR16, F.out, modv, 5, XN, SSQP(3, 9), INP(IN_NMIX) + 1024, modv + 17 * 6144, 1};
          pg8::gemm_phase<pg8::EpiRes3<false, false>, pg8::XcdOrder, true, true>(F.lds, g, S, E); }
        { Gemm g{XN, (const bf16_t*)(F.ws + WS_WOD), MROWS, ODN, 1024, 1024}; pg8::XcdOrder S; S.init(F.bid, 0, 12, 0, pos_of, 7, 16, 6, 24, 4);
          const float* gq1 = INP(IN_NAQG); const float* gk1 = INP(IN_NAKG);
          auto gf_od = [=](int g) -> pg8::ProjGroup { if (g < 16) return {1, gq1, QS_NA, 0, nullptr}; if (g < 32) return {1, gk1, 1.0f, 0, nullptr}; return {0, nullptr, 1.0f, 0, nullptr}; };
          typedef pg8::EpiProj<true, decltype(gf_od)> EpiOd;
          EpiOd E{REG, ODN, (const float*)(F.ws + WS_SSQ + 3 * SSQ_STRIDE), (const float*)(F.ws + WS_SHW + SHW_OD), 3072, ropet, gf_od};
          pg8::gemm_phase<EpiOd, pg8::XcdOrder, true, true>(F.lds, g, S, E); }
    }
    SEAM(9);
    if (PH(10)) { Gemm g{XN, (const bf16_t*)(F.ws + WS_WOD), MROWS, ODN, 1024, 1024}; pg8::XcdOrder S; S.init(F.bid, 1, 8, 4, slot32, 1, 16, 0, 16, 0);
        const float* gq1 = INP(IN_NAQG); const float* gk1 = INP(IN_NAKG);
          auto gf_od = [=](int g) -> pg8::ProjGroup { if (g < 16) return {1, gq1, QS_NA, 0, nullptr}; if (g < 32) return {1, gk1, 1.0f, 0, nullptr}; return {0, nullptr, 1.0f, 0, nullptr}; };
          typedef pg8::EpiProj<true, decltype(gf_od)> EpiOd;
          EpiOd E{REG, ODN, (const float*)(F.ws + WS_SSQ + 3 * SSQ_STRIDE), (const float*)(F.ws + WS_SHW + SHW_OD), 3072, ropet, gf_od};
        pg8::gemm_phase<EpiOd, pg8::XcdOrder, true, true>(F.lds, g, S, E); }
    SEAM(10);
    if (PH(11)) {
        for (int pr = F.bid; pr < 256; pr += F.G) { const int b = pr >> 4, h = pr & 15;
            LAS float* rp = (LAS float*)(F.lds + NA_RPB);
            __syncthreads();
            for (int i = F.tid; i < 16 * 128; i += 512) { const int dr = i >> 7, jx = (i & 127) - 48; rp[i] = (dr < 15 && jx >= 0 && jx < 31) ? INP(IN_RPB)[h * 465 + dr * 31 + jx] * LOG2E : 0.f; }
            bf16x8 qf[4];
#pragma nounroll
            for (int band = 0; band < 8; ++band) na_unit<0>(F, p, b, h, band, qf); }
    }
    SEAM(11);
    if (PH(12)) { Gemm g{Y, (const bf16_t*)(F.ws + WS_WO) + 1024 * 1024, MROWS, 1024, 1024, 1024}; LatentOrder S; S.init(1024, F.G, F.bid);
        pg8::EpiRes3<false, false> E{nullptr, nullptr, XR16, F.out, modv + 17 * 6144, 2, XN, SSQP(4, 12), INP(IN_NFFN) + 1024, modv + 17 * 6144, 4};
        pg8::gemm_phase<pg8::EpiRes3<false, false>, LatentOrder, true, true>(F.lds, g, S, E); }
    SEAM(12);
    if (PH(13)) { Gemm g{XN, (const bf16_t*)(F.ws + WS_WFI) + (size_t)5632 * 1024, MROWS, 2 * DFF, 1024, 1024}; LatentOrder S; S.init(2 * DFF, F.G, F.bid);
        pg8::EpiSwiGLU2 E{REG, (const float*)(F.ws + WS_SSQ + 4 * SSQ_STRIDE), (const float*)(F.ws + WS_SHW + SHW_F1)};
        pg8::gemm_phase<pg8::EpiSwiGLU2, LatentOrder, true, true>(F.lds, g, S, E); }
    SEAM(13);
    if (PH(14)) { Gemm g{REG, (const bf16_t*)(F.ws + WS_WFO + 6 * MiB), MROWS, 1024, DFF, HIDP}; LatentOrder S; S.init(1024, F.G, F.bid);
        pg8::EpiRes3<false, true> E{nullptr, nullptr, XR16, F.out, modv + 17 * 6144, 5, nullptr, nullptr, nullptr, modv, 0};
        pg8::gemm_phase<pg8::EpiRes3<false, true>, LatentOrder, true, true>(F.lds, g, S, E); }
#undef PH
#undef SEAM
#undef SSQP
}

#ifndef PROBE_ABL
#define PROBE_ABL 0
#endif
#ifndef N_LAUNCHES
#define N_LAUNCHES 1
#endif
extern "C" void kernel_launch(void* const* d_in, const int* in_sizes, int n_in, void* d_out, int out_size, void* d_ws, size_t ws_size, hipStream_t stream) {
    static int grid = 0;
    if (grid == 0) {
        if (n_in != 30 || out_size != NBATCH * SEQ * DM || ws_size < WS_END) { fprintf(stderr, "kernel_launch: unexpected problem: n_in %d out %d ws %zu (need %zu)\n", n_in, out_size, ws_size, (size_t)WS_END); grid = -1; return; }
        int dev = 0, cus = 0, per_cu = 0;
        if (hipGetDevice(&dev) != hipSuccess || hipDeviceGetAttribute(&cus, hipDeviceAttributeMultiprocessorCount, dev) != hipSuccess) { grid = -1; return; }
        if (hipFuncSetAttribute((const void*)fwd_kernel, hipFuncAttributeMaxDynamicSharedMemorySize, LDS_BYTES) != hipSuccess) { fprintf(stderr, "kernel_launch: hipFuncSetAttribute failed\n"); grid = -1; return; }
        if (hipOccupancyMaxActiveBlocksPerMultiprocessor(&per_cu, (const void*)fwd_kernel, 512, LDS_BYTES) != hipSuccess || per_cu < 1) { fprintf(stderr, "kernel_launch: occupancy query says %d\n", per_cu); (void)hipGetLastError(); per_cu = 1; }
        grid = cus * (per_cu > 1 ? 1 : per_cu);
        fprintf(stderr, "kernel_launch: cus %d per_cu %d grid %d ws %zu MiB\n", cus, per_cu, grid, ws_size >> 20);
        if (grid != 256) { fprintf(stderr, "kernel_launch: this build's static schedules need exactly 256 workgroups (one per CU of a 256-CU device); nothing launched\n"); grid = -1; return; }
    }
    if (grid < 0) return;
    unsigned char* ws = (unsigned char*)d_ws;
#if defined(PROBE_K) || N_LAUNCHES != 1
    (void)hipMemsetAsync(ws + WS_CTL, 0, CTL_ZERO_BYTES, stream);
#endif
    Params p{};
    for (int i = 0; i < 30; ++i) p.in[i] = (const float*)d_in[i];
    p.out = (float*)d_out; p.ws = ws;
#if defined(PROBE_K)
    for (int li = 0; li < 2; ++li) { p.ph_lo = li == 0 ? 0 : PROBE_K; p.ph_hi = li == 0 ? PROBE_K + PROBE_REP : N_PHASES; p.abl = li == 0 ? PROBE_ABL : 0;
        if (li == 1) (void)hipMemsetAsync(ws + WS_CTL, 0, CTL_ZERO_BYTES, stream);
        void* args[] = {&p};
        hipError_t e = hipLaunchCooperativeKernel((void*)fwd_kernel, dim3(grid), dim3(512), args, LDS_BYTES, stream);
        if (e != hipSuccess) fprintf(stderr, "cooperative launch failed: %s (grid %d)\n", hipGetErrorString(e), grid); }
#elif N_LAUNCHES == 1
    p.ph_lo = 0; p.ph_hi = N_PHASES;
    void* args[] = {&p};
    hipError_t e = hipLaunchCooperativeKernel((void*)fwd_kernel, dim3(grid), dim3(512), args, LDS_BYTES, stream);
    if (e != hipSuccess) fprintf(stderr, "cooperative launch failed: %s (grid %d)\n", hipGetErrorString(e), grid);
#else
    for (int k = 0; k < N_PHASES; ++k) { p.ph_lo = k; p.ph_hi = k + 1; hipLaunchKernelGGL(fwd_kernel, dim3(grid), dim3(512), LDS_BYTES, stream, p); }
#endif
}
```

```cpp
#include <hip/hip_runtime.h>
#include <hip/hip_cooperative_groups.h>
#include <cstdio>
#include <cstdint>
namespace cg = cooperative_groups;

namespace pg8 {
#define PG8_LAS __attribute__((address_space(3)))
typedef unsigned short bf16_t;
typedef short bf16x8 __attribute__((ext_vector_type(8)));
typedef float f32x4 __attribute__((ext_vector_type(4)));
typedef unsigned u32x4 __attribute__((ext_vector_type(4)));
constexpr int BM = 256, BK = 64, HALF = 128, HTB = HALF * BK * 2  , STAGE_BYTES = 8 * HTB, NXCD = 8, WGM = 8;

__host__ __device__ __forceinline__ int lds_byte(int r, int c) { const int st = (r >> 4) * 2 + (c >> 5), rr = r & 15, cc = c & 31, ob = rr * 64 + cc * 2; return st * 1024 + (ob ^ (((ob >> 9) & 1) << 5)); }
__host__ __device__ __forceinline__ void stage_rc(int b, int& R, int& C) { const int st = b / 1024, sb = b % 1024, swz = sb ^ (((sb >> 9) & 1) << 5); R = (st >> 1) * 16 + swz / 64; C = (st & 1) * 32 + (swz % 64) / 2; }
__host__ __device__ __forceinline__ int perm32(int rho) { const int n = rho >> 4, i = rho & 15; return 8 * (i >> 2) + 4 * n + (i & 3); }

struct Unit { int pm, pn, aoff; };
struct Gemm { const bf16_t* A; const bf16_t* Bt; int M, N, K, lda; };

struct StaticOrder {
    int nM, nN, nwg, G, c;
    __host__ __device__ void init(int M, int N, int G_, int c_) { nM = M / BM; nN = N / BM; nwg = nM * nN; G = G_; c = c_; }
    __host__ __device__ bool next(int i, Unit& u) const {
        const long L = (long)i * G + c; if (L >= nwg) return false;
        int wgid = (int)L; { const int q = nwg / NXCD, r = nwg % NXCD, xcd = wgid % NXCD, off = wgid / NXCD; wgid = (xcd < r ? xcd * (q + 1) : r * (q + 1) + (xcd - r) * q) + off; }
        const int nig = WGM * nN, gid = wgid / nig, fm = gid * WGM, gsz = (nM - fm) < WGM ? (nM - fm) : WGM;
        u.pm = fm + ((wgid % nig) % gsz); u.pn = (wgid % nig) / gsz; u.aoff = 0; return true;
    }
    __device__ __forceinline__ void a_ready(const Unit&) const {}
    __device__ __forceinline__ void done(const Unit&) const {}
};

typedef float f32x2_t __attribute__((ext_vector_type(2))); typedef __bf16 bf16x2_t __attribute__((ext_vector_type(2))); typedef unsigned u32x2 __attribute__((ext_vector_type(2)));
__device__ __forceinline__ unsigned cvtpk(float lo, float hi) { f32x2_t v = {lo, hi}; bf16x2_t b = __builtin_convertvector(v, bf16x2_t); return __builtin_bit_cast(unsigned, b); }


template <int N> __device__ __forceinline__ float dpp_ror_add(float v) { return v + __builtin_bit_cast(float, __builtin_amdgcn_update_dpp(0, __builtin_bit_cast(int, v), 0x120 + N, 0xf, 0xf, false)); }
__device__ __forceinline__ float sum_xor16(float v) { return v + __shfl_xor(v, 16); }
__device__ __forceinline__ void swap32(float& a, float& b) { asm volatile("v_nop\n\tv_nop\n\tv_permlane32_swap_b32 %0, %1" : "+v"(a), "+v"(b)); }
__device__ __forceinline__ float sum_xor32(float v) { float a = v, b = v; swap32(a, b); return a + b; }
__device__ __forceinline__ float partner_xor32(float v, bool upper) { float a = v, b = v; swap32(a, b); return upper ? a : b; }
__device__ __forceinline__ float wave_sum_fast(float v) { v += __shfl_xor(v, 1); v += __shfl_xor(v, 2); v += __shfl_xor(v, 4); v += __shfl_xor(v, 8); v += __shfl_xor(v, 16); return sum_xor32(v); }
struct LatentOrder : StaticOrder {
    __host__ __device__ void init(int N, int G_, int c_) { StaticOrder::init(128 * BM, N, G_, c_); }
    __host__ __device__ bool next(int i, Unit& u) const { if (!StaticOrder::next(i, u)) return false; u.pm = u.pm + u.pm / 8 + 1; return true; }
};


struct XcdOrder {
    int tile0, p, kind, gsz, nN, pn0, n, nB, nC, PA, PB;
    __host__ __device__ void init(int c, int kind_, int nN_, int pn0_, int pos, int nA_, int PA_, int nB_, int PB_, int nC_) {
        const int tp = kind_ == 0 ? 16 : 2; tile0 = tp * (c & 7); gsz = tp < 8 ? tp : 8; p = pos; kind = kind_; nN = nN_; pn0 = pn0_; nB = nB_; nC = nC_; PA = PA_; PB = PB_;
        int n_ = nC_; if (pos < PB_) n_ = nB_; if (pos < PA_) n_ = nA_; n = n_; }
    __host__ __device__ bool next(int i, Unit& u) const {
        if (i >= n) return false;
        const int i1 = i < nC ? i : nC, i2 = i - nC < 0 ? 0 : (i - nC > nB - nC ? nB - nC : i - nC), i3 = i - nB < 0 ? 0 : i - nB;
        const int w = 32 * i1 + PB * i2 + PA * i3 + p;
        const int nig = gsz * nN, grp = w / nig, r = w % nig, t = tile0 + grp * gsz + r % gsz;
        u.pn = pn0 + r / gsz; u.pm = kind == 0 ? t + t / 8 + 1 : 9 * t; u.aoff = 0; return true;
    }
    __device__ __forceinline__ void a_ready(const Unit&) const {}
    __device__ __forceinline__ void done(const Unit&) const {}
};
struct EpiStore {
    static constexpr bool PERM = true, AFTER_DRAIN = false;
    bf16_t* O; int ldc;
    __device__ __forceinline__ void operator()(const f32x4 (&acc)[2][2][4][2], const Unit& u, int wr, int wc, int fr, int fq) const {
        const int row0 = u.pm * BM + wr * 64 + fr, col0 = u.pn * BM + wc * 32 + 8 * fq;
#pragma unroll
        for (int ai = 0; ai < 2; ++ai)
#pragma unroll
            for (int m = 0; m < 4; ++m) { bf16_t* rowp = O + (size_t)(row0 + ai * HALF + m * 16) * ldc + col0;
#pragma unroll
                for (int bj = 0; bj < 2; ++bj) { const f32x4 v0 = acc[ai][bj][m][0], v1 = acc[ai][bj][m][1];
                    u32x4 w; w.x = cvtpk(v0[0], v0[1]); w.y = cvtpk(v0[2], v0[3]); w.z = cvtpk(v1[0], v1[1]); w.w = cvtpk(v1[2], v1[3]);
                    *(u32x4*)(rowp + bj * HALF) = w; } }
    }
};
struct EpiRes {
    static constexpr bool PERM = false, AFTER_DRAIN = false;
    const float* base_lat; const float* base_ctx; float* out_lat; float* out_ctx; const float* modv_l; int chunk;
    __device__ __forceinline__ void operator()(const f32x4 (&acc)[2][2][4][2], const Unit& u, int wr, int wc, int fr, int fq) const {
        asm volatile("" : "+v"(fr), "+v"(fq) :: "memory");
        const int b = u.pm / 9, j = u.pm % 9;
        const float* __restrict__ bp; float* __restrict__ op; const float* gv;
        if (j == 0) { const size_t off = (size_t)b * 256 * 1024; bp = base_ctx + off; op = out_ctx + off; gv = modv_l + 16 * 6144 + chunk * 1024; }
        else { const size_t off = ((size_t)b * 2048 + (size_t)(j - 1) * 256) * 1024; bp = base_lat + off; op = out_lat + off; gv = modv_l + b * 6144 + chunk * 1024; }
        const int rl0 = wr * 64 + fr, col0 = u.pn * BM + wc * 32 + 4 * fq;
        f32x4 g[2][2];
#pragma unroll
        for (int bj = 0; bj < 2; ++bj)
#pragma unroll
            for (int n = 0; n < 2; ++n) g[bj][n] = *(const f32x4*)(gv + col0 + bj * HALF + n * 16);
#pragma unroll
        for (int ai = 0; ai < 2; ++ai)
#pragma unroll
            for (int m = 0; m < 4; ++m) { const size_t ro = (size_t)(rl0 + ai * HALF + m * 16) * 1024 + col0;
#pragma unroll
                for (int bj = 0; bj < 2; ++bj)
#pragma unroll
                    for (int n = 0; n < 2; ++n) { const f32x4 bs = *(const f32x4*)(bp + ro + bj * HALF + n * 16);
                        *(f32x4*)(op + ro + bj * HALF + n * 16) = bs + g[bj][n] * acc[ai][bj][m][n]; } }
    }
};
__device__ __forceinline__ float silu_mul(float g, float u) { return g * u * __builtin_amdgcn_rcpf(1.0f + __builtin_amdgcn_exp2f(-1.4426950408889634f * g)); }
struct EpiSwiGLU {
    static constexpr bool PERM = true, AFTER_DRAIN = false;
    bf16_t* H;
    __device__ __forceinline__ void operator()(const f32x4 (&acc)[2][2][4][2], const Unit& u, int wr, int wc, int fr, int fq) const {
        const int row0 = u.pm * BM + wr * 64 + fr, col0 = u.pn * HALF + wc * 32 + 8 * fq;
#pragma unroll
        for (int ai = 0; ai < 2; ++ai)
#pragma unroll
            for (int m = 0; m < 4; ++m) { bf16_t* rowp = H + (size_t)(row0 + ai * HALF + m * 16) * 2816 + col0;
                const f32x4 g0 = acc[ai][0][m][0], g1 = acc[ai][0][m][1], u0 = acc[ai][1][m][0], u1 = acc[ai][1][m][1];
                u32x4 w; w.x = cvtpk(silu_mul(g0[0], u0[0]), silu_mul(g0[1], u0[1])); w.y = cvtpk(silu_mul(g0[2], u0[2]), silu_mul(g0[3], u0[3]));
                w.z = cvtpk(silu_mul(g1[0], u1[0]), silu_mul(g1[1], u1[1])); w.w = cvtpk(silu_mul(g1[2], u1[2]), silu_mul(g1[3], u1[3]));
                *(u32x4*)rowp = w; }
    }
};

struct UpOrder : StaticOrder {
    __host__ __device__ bool next(int i, Unit& u) const { if (!StaticOrder::next(i, u)) return false; u.aoff = (u.pn < 3 ? 1536 : 1792) * 2; return true; }
};
struct EpiUp {
    static constexpr bool PERM = true, AFTER_DRAIN = false;
    bf16_t* Q; bf16_t* KV;
    const float* ssq_cq; const float* ssq_ckv;
    __device__ __forceinline__ void operator()(const f32x4 (&acc)[2][2][4][2], const Unit& u, int wr, int wc, int fr, int fq) const {
        asm volatile("" : "+v"(fr), "+v"(fq) :: "memory");
        const bool isq = u.pn < 3; bf16_t* O = isq ? Q : KV; const int ldc = isq ? 768 : 1024;
        const int row0 = u.pm * BM + wr * 64 + fr, col0 = (isq ? u.pn : u.pn - 3) * BM + wc * 32 + 8 * fq;
        const float* sq = isq ? ssq_cq : ssq_ckv; const float inv = isq ? (1.0f / 256.0f) : (1.0f / 128.0f);
        float rs[2][4];
#pragma unroll
        for (int ai = 0; ai < 2; ++ai)
#pragma unroll
            for (int m = 0; m < 4; ++m) rs[ai][m] = 1.0f / sqrtf(sq[row0 + ai * HALF + m * 16] * inv + 1e-6f);
#pragma unroll
        for (int ai = 0; ai < 2; ++ai)
#pragma unroll
            for (int m = 0; m < 4; ++m) { bf16_t* rowp = O + (size_t)(row0 + ai * HALF + m * 16) * ldc + col0;
#pragma unroll
                for (int bj = 0; bj < 2; ++bj) { const f32x4 v0 = acc[ai][bj][m][0] * rs[ai][m], v1 = acc[ai][bj][m][1] * rs[ai][m];
                    u32x4 w; w.x = cvtpk(v0[0], v0[1]); w.y = cvtpk(v0[2], v0[3]); w.z = cvtpk(v1[0], v1[1]); w.w = cvtpk(v1[2], v1[3]);
                    *(u32x4*)(rowp + bj * HALF) = w; } }
    }
};
struct ProjGroup { int kind; const float* gain; float oscale; int rope; float* ssq; };
template <bool NORMIN, class GroupFn> struct EpiProj {
    static constexpr bool PERM = true, AFTER_DRAIN = false;
    bf16_t* O; int ldc;
    const float* ssq_in; const float* shw; int shw_ld;
    const float* ropet;
    GroupFn gf;
    __device__ __forceinline__ void operator()(const f32x4 (&acc)[2][2][4][2], const Unit& u, int wr, int wc, int fr, int fq) const {
        asm volatile("" : "+v"(fr), "+v"(fq) :: "memory");
        const int g = 4 * u.pn + wc; const ProjGroup G = gf(g);
        const int b = u.pm / 9, j = u.pm % 9; const bool lat = j != 0; const int midx = lat ? b : 16;
        const int row0 = u.pm * BM + wr * 64 + fr;
        f32x4 shv[2][2], gn[2][2]; float rin[2][4];
#pragma unroll
        for (int bj = 0; bj < 2; ++bj)
#pragma unroll
            for (int n = 0; n < 2; ++n) { shv[bj][n] = NORMIN ? *(const f32x4*)(shw + (size_t)midx * shw_ld + u.pn * BM + bj * HALF + wc * 32 + 8 * fq + 4 * n) : (f32x4){0.f, 0.f, 0.f, 0.f};
                gn[bj][n] = (G.kind == 1) ? *(const f32x4*)(G.gain + 32 * bj + 8 * fq + 4 * n) : (f32x4){1.f, 1.f, 1.f, 1.f}; }
#pragma unroll
        for (int ai = 0; ai < 2; ++ai)
#pragma unroll
            for (int m = 0; m < 4; ++m) rin[ai][m] = NORMIN ? 1.0f / sqrtf(ssq_in[row0 + ai * HALF + m * 16] * (1.0f / 1024.0f) + 1e-6f) : 1.0f;
        if (!NORMIN) { const float dl = ropet[fq]; asm volatile("" :: "v"(dl)); }
        const bool do_rope = (G.kind == 1) && G.rope && lat;
        float invr[2][4];
#pragma unroll
        for (int n = 0; n < 2; ++n)
#pragma unroll
            for (int i = 0; i < 4; ++i) invr[n][i] = __builtin_amdgcn_exp2f(-(float)(8 * (fq & 1) + 4 * n + i) * 0.8304820237218405f) * 0.15915494309189535f;
#pragma unroll
        for (int ai = 0; ai < 2; ++ai)
#pragma unroll
            for (int m = 0; m < 4; ++m) {
                const int row = row0 + ai * HALF + m * 16;
                f32x4 v[2][2];
#pragma unroll
                for (int bj = 0; bj < 2; ++bj)
#pragma unroll
                    for (int n = 0; n < 2; ++n) v[bj][n] = NORMIN ? acc[ai][bj][m][n] * rin[ai][m] + shv[bj][n] : acc[ai][bj][m][n];
                if (G.kind != 0) {
                    float ss = 0.f;
#pragma unroll
                    for (int bj = 0; bj < 2; ++bj)
#pragma unroll
                        for (int n = 0; n < 2; ++n) ss += (v[bj][n][0] * v[bj][n][0] + v[bj][n][1] * v[bj][n][1]) + (v[bj][n][2] * v[bj][n][2] + v[bj][n][3] * v[bj][n][3]);
                    ss = sum_xor32(sum_xor16(ss));
                    if (G.kind == 2) { if (fq == 0) atomicAdd(G.ssq + row, ss); }
                    else {
                        const float rstd = 1.0f / sqrtf(ss * (1.0f / 64.0f) + 1e-6f);
#pragma unroll
                        for (int bj = 0; bj < 2; ++bj)
#pragma unroll
                            for (int n = 0; n < 2; ++n) v[bj][n] = v[bj][n] * rstd * gn[bj][n];
                        if (do_rope) {
                            const float prow = (float)(4 * (j - 1) + 2 * ai + wr), pcol = (float)(16 * m + fr);
#pragma unroll
                            for (int bj = 0; bj < 2; ++bj)
#pragma unroll
                                for (int n = 0; n < 2; ++n)
#pragma unroll
                                    for (int i = 0; i < 4; ++i) { const float rev = (bj == 0 ? prow : pcol) * invr[n][i], frc = rev - floorf(rev);
                                        const float cs = __builtin_amdgcn_cosf(frc), sn = __builtin_amdgcn_sinf(frc), x = v[bj][n][i], pv = partner_xor32(x, (fq & 2) != 0);
                                        v[bj][n][i] = (fq & 2) ? (pv * sn + x * cs) : (x * cs - pv * sn); }
                        }
#pragma unroll
                        for (int bj = 0; bj < 2; ++bj)
#pragma unroll
                            for (int n = 0; n < 2; ++n) v[bj][n] = v[bj][n] * G.oscale;
                    }
                }
                bf16_t* rowp = O + (size_t)row * ldc + 64 * g + 8 * fq;
#pragma unroll
                for (int bj = 0; bj < 2; ++bj) { u32x4 w; w.x = cvtpk(v[bj][0][0], v[bj][0][1]); w.y = cvtpk(v[bj][0][2], v[bj][0][3]); w.z = cvtpk(v[bj][1][0], v[bj][1][1]); w.w = cvtpk(v[bj][1][2], v[bj][1][3]);
                    *(u32x4*)(rowp + 32 * bj) = w; }
            }
    }
};
template <bool BASE_F32, bool FINAL> struct EpiRes3 {
    static constexpr bool PERM = false, AFTER_DRAIN = false;
    const float* base_lat; const float* base_ctx; bf16_t* xr; float* out_lat; const float* modv_l; int chunk;
    bf16_t* xn; float* ssq; const float* gain_n; const float* modv_n; int chunk_n;
    __device__ __forceinline__ void operator()(const f32x4 (&acc)[2][2][4][2], const Unit& u, int wr, int wc, int fr, int fq) const {
        asm volatile("" : "+v"(fr), "+v"(fq) :: "memory");
        const int b = u.pm / 9, j = u.pm % 9; const int midx = (j == 0) ? 16 : b;
        const float* __restrict__ bp = (j == 0) ? base_ctx + (size_t)b * 256 * 1024 : base_lat + ((size_t)b * 2048 + (size_t)(j - 1) * 256) * 1024;
        float* __restrict__ op = out_lat + ((size_t)b * 2048 + (size_t)(j - 1) * 256) * 1024;
        bf16_t* __restrict__ xrp = xr + (size_t)u.pm * BM * 1024;
        bf16_t* __restrict__ xnp = xn + (size_t)u.pm * BM * 1024;
        const float* gv = modv_l + midx * 6144 + chunk * 1024; const float* sv = modv_n + midx * 6144 + chunk_n * 1024;
        const int rl0 = wr * 64 + fr, col0 = u.pn * BM + wc * 32 + 4 * fq;
        float ss[2][4];
#pragma unroll
        for (int ai = 0; ai < 2; ++ai)
#pragma unroll
            for (int m = 0; m < 4; ++m) ss[ai][m] = 0.f;
#pragma unroll
        for (int bj = 0; bj < 2; ++bj)
#pragma unroll
            for (int n = 0; n < 2; ++n) { const int col = col0 + bj * HALF + n * 16;
                const f32x4 g4v = *(const f32x4*)(gv + col);
                f32x4 gs4v = (f32x4){0.f, 0.f, 0.f, 0.f}; if (!FINAL) gs4v = *(const f32x4*)(gain_n + col) * (*(const f32x4*)(sv + col) + 1.0f);
                f32x4 bs[2][4];
#pragma unroll
                for (int ai = 0; ai < 2; ++ai)
#pragma unroll
                    for (int m = 0; m < 4; ++m) { const size_t ro = (size_t)(rl0 + ai * HALF + m * 16) * 1024 + col;
                        if (BASE_F32) bs[ai][m] = *(const f32x4*)(bp + ro);
                        else { const u32x2 w = *(const u32x2*)(xrp + ro); bs[ai][m] = (f32x4){__uint_as_float(w.x << 16), __uint_as_float(w.x & 0xffff0000u), __uint_as_float(w.y << 16), __uint_as_float(w.y & 0xffff0000u)}; } }
#pragma unroll
                for (int ai = 0; ai < 2; ++ai)
#pragma unroll
                    for (int m = 0; m < 4; ++m) { const size_t ro = (size_t)(rl0 + ai * HALF + m * 16) * 1024 + col;
                        const f32x4 x = bs[ai][m] + g4v * acc[ai][bj][m][n];
                        if (FINAL) *(f32x4*)(op + ro) = x;
                        else { u32x2 w; w.x = cvtpk(x[0], x[1]); w.y = cvtpk(x[2], x[3]); *(u32x2*)(xrp + ro) = w;
                            ss[ai][m] += (x[0] * x[0] + x[1] * x[1]) + (x[2] * x[2] + x[3] * x[3]);
                            const f32x4 h = x * gs4v; u32x2 w2; w2.x = cvtpk(h[0], h[1]); w2.y = cvtpk(h[2], h[3]);
                            *(u32x2*)(xnp + ro) = w2; } } }
        if (!FINAL) {
#pragma unroll
            for (int ai = 0; ai < 2; ++ai)
#pragma unroll
                for (int m = 0; m < 4; ++m) { const float s2 = sum_xor32(sum_xor16(ss[ai][m])); if (fq == 0) atomicAdd(ssq + u.pm * BM + rl0 + ai * HALF + m * 16, s2); } }
    }
};
struct EpiSwiGLU2 {
    static constexpr bool PERM = true, AFTER_DRAIN = false;
    bf16_t* H; const float* ssq_in; const float* shw;
    __device__ __forceinline__ void operator()(const f32x4 (&acc)[2][2][4][2], const Unit& u, int wr, int wc, int fr, int fq) const {
        asm volatile("" : "+v"(fr), "+v"(fq) :: "memory");
        const int b = u.pm / 9, j = u.pm % 9; const int midx = (j == 0) ? 16 : b;
        const int row0 = u.pm * BM + wr * 64 + fr, col0 = u.pn * HALF + wc * 32 + 8 * fq;
        const float* sp = shw + (size_t)midx * 5632 + u.pn * BM + wc * 32 + 8 * fq;
        const f32x4 sg0 = *(const f32x4*)(sp), sg1 = *(const f32x4*)(sp + 4), su0 = *(const f32x4*)(sp + HALF), su1 = *(const f32x4*)(sp + HALF + 4);
        float rinv[2][4];
#pragma unroll
        for (int ai = 0; ai < 2; ++ai)
#pragma unroll
            for (int m = 0; m < 4; ++m) rinv[ai][m] = 1.0f / sqrtf(ssq_in[row0 + ai * HALF + m * 16] * (1.0f / 1024.0f) + 1e-6f);
#pragma unroll
        for (int ai = 0; ai < 2; ++ai)
#pragma unroll
            for (int m = 0; m < 4; ++m) { const int row = row0 + ai * HALF + m * 16; bf16_t* rowp = H + (size_t)row * 3072 + col0;
                const float rin = rinv[ai][m];
                const f32x4 g0 = acc[ai][0][m][0] * rin + sg0, g1 = acc[ai][0][m][1] * rin + sg1, u0 = acc[ai][1][m][0] * rin + su0, u1 = acc[ai][1][m][1] * rin + su1;
                u32x4 w; w.x = cvtpk(silu_mul(g0[0], u0[0]), silu_mul(g0[1], u0[1])); w.y = cvtpk(silu_mul(g0[2], u0[2]), silu_mul(g0[3], u0[3]));
                w.z = cvtpk(silu_mul(g1[0], u1[0]), silu_mul(g1[1], u1[1])); w.w = cvtpk(silu_mul(g1[2], u1[2]), silu_mul(g1[3], u1[3]));
                *(u32x4*)rowp = w; }
    }
};

template <class Epi, class Sched, bool ALIGN_EPI = false, bool SP2 = false>
__device__ __forceinline__ void gemm_phase(PG8_LAS unsigned char* lds, const Gemm g, const Sched& S, const Epi& E) {
    const int tid = threadIdx.x, wid = __builtin_amdgcn_readfirstlane(tid >> 6), lane = tid & 63, wr = wid >> 2, wc = wid & 3, fr = lane & 15, fq = lane >> 4;
    const int K = g.K, nt = K / BK;
    unsigned voffA[2], voffB[2];
#pragma unroll
    for (int i = 0; i < 2; ++i) { int R, C; stage_rc(tid * 16 + i * 8192, R, C); const int Rb = Epi::PERM ? ((R & ~31) + perm32(R & 31)) : R;
        voffA[i] = (unsigned)(R * g.lda + C) * 2u; voffB[i] = (unsigned)(Rb * K + C) * 2u; }
    const size_t kstep = (size_t)(BK * 2);
    const size_t hstepB = (size_t)HALF * K * 2, hstepA = (size_t)HALF * g.lda * 2;
    const size_t tstepB = 2 * hstepB, tstepA = 2 * hstepA;
    const unsigned ldsw = (unsigned)wid * 1024u;
    const int aoff = lds_byte(wr * 64 + fr, fq * 8), boff = lds_byte(wc * 32 + fr, fq * 8);
#define PG8_SA(b, h) (((b) * 2 + (h)) * HTB)
#define PG8_SB(b, h) ((4 + (b) * 2 + (h)) * HTB)
#define PG8_STAGE(bufoff, gbase, voff) do { _Pragma("unroll") for (int _i = 0; _i < 2; ++_i) \
        __builtin_amdgcn_global_load_lds((const unsigned*)((const char*)(gbase) + (voff)[_i]), (PG8_LAS unsigned*)(lds + (bufoff) + ldsw + _i * 8192), 16, 0, 0); } while (0)
#define PG8_LDA(dst, b, h) do { _Pragma("unroll") for (int m = 0; m < 4; ++m) _Pragma("unroll") for (int k = 0; k < 2; ++k) dst[m][k] = *(const PG8_LAS bf16x8*)(lds + PG8_SA(b, h) + aoff + m * 2048 + k * 1024); } while (0)
#define PG8_LDB(dst, b, h) do { _Pragma("unroll") for (int n = 0; n < 2; ++n) _Pragma("unroll") for (int k = 0; k < 2; ++k) dst[n][k] = *(const PG8_LAS bf16x8*)(lds + PG8_SB(b, h) + boff + n * 2048 + k * 1024); } while (0)
#define PG8_MMA(ai, bj, At, Bt) do { __builtin_amdgcn_s_setprio(1); _Pragma("unroll") for (int m = 0; m < 4; ++m) _Pragma("unroll") for (int n = 0; n < 2; ++n) _Pragma("unroll") for (int k = 0; k < 2; ++k) \
        acc[ai][bj][m][n] = __builtin_amdgcn_mfma_f32_16x16x32_bf16(Bt[n][k], At[m][k], acc[ai][bj][m][n], 0, 0, 0); __builtin_amdgcn_s_setprio(0); } while (0)
#define PG8_WAIT_V(n) asm volatile("s_waitcnt vmcnt(" #n ")" ::: "memory")
#define PG8_WAIT_L(n) asm volatile("s_waitcnt lgkmcnt(" #n ")" ::: "memory")
#define PG8_BAR __builtin_amdgcn_s_barrier()
#define PG8_SCHED __builtin_amdgcn_sched_barrier(0)
    Unit cur, nxt; int ui = 0;
    if (!S.next(0, cur)) return;
    f32x4 acc[2][2][4][2];
#pragma unroll
    for (int a = 0; a < 2; ++a)
#pragma unroll
        for (int b = 0; b < 2; ++b)
#pragma unroll
            for (int m = 0; m < 4; ++m)
#pragma unroll
                for (int n = 0; n < 2; ++n) acc[a][b][m][n] = (f32x4){0.f, 0.f, 0.f, 0.f};
    bf16x8 At[4][2], B0[2][2], B1[2][2];
    const char* cA = (const char*)g.A + (size_t)cur.pm * tstepA + cur.aoff; const char* cB = (const char*)g.Bt + (size_t)cur.pn * tstepB;
    S.a_ready(cur);
    if constexpr (SP2) {
        PG8_STAGE(PG8_SB(0, 0), cB, voffB); PG8_STAGE(PG8_SB(0, 1), cB + hstepB, voffB); PG8_STAGE(PG8_SA(0, 0), cA, voffA); PG8_STAGE(PG8_SA(0, 1), cA + hstepA, voffA);
        if (wr == 1) PG8_BAR;
        PG8_WAIT_V(2); PG8_BAR;
        PG8_STAGE(PG8_SB(1, 0), cB + kstep, voffB); PG8_STAGE(PG8_SA(1, 0), cA + kstep, voffA); PG8_STAGE(PG8_SB(1, 1), cB + hstepB + kstep, voffB);
        PG8_WAIT_V(6); PG8_BAR;
    } else {
        PG8_STAGE(PG8_SB(0, 0), cB, voffB); PG8_STAGE(PG8_SA(0, 0), cA, voffA); PG8_STAGE(PG8_SB(0, 1), cB + hstepB, voffB); PG8_STAGE(PG8_SA(0, 1), cA + hstepA, voffA);
        if (wr == 1) PG8_BAR;
        PG8_WAIT_V(4); PG8_BAR;
        PG8_STAGE(PG8_SB(1, 0), cB + kstep, voffB); PG8_STAGE(PG8_SA(1, 0), cA + kstep, voffA); PG8_STAGE(PG8_SB(1, 1), cB + hstepB + kstep, voffB);
        PG8_WAIT_V(6); PG8_BAR;
    }
    for (;;) {
        const bool has_next = S.next(ui + 1, nxt);
        const char* nA = has_next ? (const char*)g.A + (size_t)nxt.pm * tstepA + nxt.aoff : cA; const char* nB = has_next ? (const char*)g.Bt + (size_t)nxt.pn * tstepB : cB;
        for (int t = 0; t < nt; t += 2) {
            const bool last = (t == nt - 2);
            const char* a1 = cA + (size_t)(t + 1) * kstep;
            const char* a2 = last ? nA : cA + (size_t)(t + 2) * kstep; const char* b2 = last ? nB : cB + (size_t)(t + 2) * kstep;
            const char* a3 = a2 + kstep; const char* b3 = b2 + kstep;
            if (last && has_next) S.a_ready(nxt);
            if constexpr (SP2) {
            PG8_LDB(B0, 0, 0); PG8_LDB(B1, 0, 1); PG8_SCHED; PG8_LDA(At, 0, 0); PG8_STAGE(PG8_SA(1, 1), a1 + hstepA, voffA);
            PG8_WAIT_V(8); PG8_WAIT_L(0); PG8_BAR; PG8_MMA(0, 0, At, B0); PG8_MMA(0, 1, At, B1); PG8_BAR; PG8_SCHED;
            PG8_LDA(At, 0, 1); PG8_STAGE(PG8_SB(0, 0), b2, voffB); PG8_STAGE(PG8_SB(0, 1), b2 + hstepB, voffB); PG8_STAGE(PG8_SA(0, 0), a2, voffA);
            PG8_WAIT_V(8); PG8_WAIT_L(0); PG8_BAR; PG8_MMA(1, 0, At, B0); PG8_MMA(1, 1, At, B1); PG8_BAR; PG8_SCHED;
            PG8_LDB(B0, 1, 0); PG8_LDB(B1, 1, 1); PG8_SCHED; PG8_LDA(At, 1, 0); PG8_STAGE(PG8_SA(0, 1), a2 + hstepA, voffA);
            PG8_WAIT_V(8); PG8_WAIT_L(0); PG8_BAR; PG8_MMA(0, 0, At, B0); PG8_MMA(0, 1, At, B1); PG8_BAR; PG8_SCHED;
            PG8_LDA(At, 1, 1); PG8_STAGE(PG8_SB(1, 0), b3, voffB); PG8_STAGE(PG8_SB(1, 1), b3 + hstepB, voffB); PG8_STAGE(PG8_SA(1, 0), a3, voffA);
            PG8_WAIT_V(8); PG8_WAIT_L(0); PG8_BAR; PG8_MMA(1, 0, At, B0); PG8_MMA(1, 1, At, B1); PG8_BAR; PG8_SCHED;
            } else {
            PG8_LDB(B0, 0, 0); PG8_SCHED; PG8_LDA(At, 0, 0); PG8_STAGE(PG8_SA(1, 1), a1 + hstepA, voffA);
            PG8_WAIT_L(8); PG8_BAR; PG8_WAIT_L(0); PG8_MMA(0, 0, At, B0); PG8_BAR; PG8_SCHED;
            PG8_LDB(B1, 0, 1); PG8_STAGE(PG8_SB(0, 0), b2, voffB);
            PG8_BAR; PG8_WAIT_L(0); PG8_MMA(0, 1, At, B1); PG8_BAR;
            PG8_LDA(At, 0, 1); PG8_STAGE(PG8_SA(0, 0), a2, voffA);
            PG8_BAR; PG8_WAIT_L(0); PG8_MMA(1, 0, At, B0); PG8_BAR; PG8_SCHED;
            PG8_STAGE(PG8_SB(0, 1), b2 + hstepB, voffB);
            PG8_WAIT_V(6); PG8_BAR; PG8_MMA(1, 1, At, B1); PG8_BAR;
            PG8_LDB(B0, 1, 0); PG8_SCHED; PG8_LDA(At, 1, 0); PG8_STAGE(PG8_SA(0, 1), a2 + hstepA, voffA);
            PG8_WAIT_L(8); PG8_BAR; PG8_WAIT_L(0); PG8_MMA(0, 0, At, B0); PG8_BAR; PG8_SCHED;
            PG8_LDB(B1, 1, 1); PG8_STAGE(PG8_SB(1, 0), b3, voffB);
            PG8_BAR; PG8_WAIT_L(0); PG8_MMA(0, 1, At, B1); PG8_BAR;
            PG8_LDA(At, 1, 1); PG8_STAGE(PG8_SA(1, 0), a3, voffA);
            PG8_BAR; PG8_WAIT_L(0); PG8_MMA(1, 0, At, B0); PG8_BAR; PG8_SCHED;
            PG8_STAGE(PG8_SB(1, 1), b3 + hstepB, voffB);
            PG8_WAIT_V(6); PG8_BAR; PG8_MMA(1, 1, At, B1); PG8_BAR;
            }
        }
        if constexpr (ALIGN_EPI) { if (wr == 0) PG8_BAR; }
        if constexpr (!Epi::AFTER_DRAIN) { E(acc, cur, wr, wc, fr, fq); S.done(cur); }
        if (!has_next) break;
#pragma unroll
        for (int a = 0; a < 2; ++a)
#pragma unroll
            for (int b = 0; b < 2; ++b)
#pragma unroll
                for (int m = 0; m < 4; ++m)
#pragma unroll
                    for (int n = 0; n < 2; ++n) acc[a][b][m][n] = (f32x4){0.f, 0.f, 0.f, 0.f};
        cur = nxt; cA = nA; cB = nB; ++ui;
        if constexpr (ALIGN_EPI) { if (wr == 1) PG8_BAR; }
    }
    PG8_WAIT_V(0);
    if constexpr (!ALIGN_EPI) { if (wr == 0) PG8_BAR; }
    PG8_BAR;
    if constexpr (Epi::AFTER_DRAIN) { E.fused(acc, cur, wr, wc, fr, fq, lds, wid, lane); S.done(cur); }
#undef PG8_SA
#undef PG8_SB
#undef PG8_STAGE
#undef PG8_LDA
#undef PG8_LDB
#undef PG8_MMA
#undef PG8_WAIT_V
#undef PG8_WAIT_L
#undef PG8_BAR
#undef PG8_SCHED
}
}

constexpr int DM = 1024, NBATCH = 16, SEQ = 2048, CTXL = 256, TU = SEQ + CTXL  , MROWS = NBATCH * TU  ;
constexpr int EVN = 1984, EVNP = 2048, DFF = 2816, ODN = 3072, HIDP = 3072  ;
constexpr float EPS = 1e-6f, LOG2E = 1.4426950408889634f;
constexpr float QS_DA = 0.125f * LOG2E, QS_NA = 0.125f * LOG2E, QS_MLA = 0.07216878364870322f * LOG2E;
constexpr float LAM_INIT0 = 0.2f;

constexpr size_t MiB = 1u << 20;
constexpr size_t WS_CTL = 0, CTL_ZERO_BYTES = 1 * MiB;
constexpr size_t WS_MODV = 1 * MiB;
constexpr size_t WS_SMALL = 2 * MiB;
constexpr size_t WS_SSQ = WS_SMALL + 65536, SSQ_STRIDE = 163840;
constexpr size_t WS_WUQ = 3 * MiB;
constexpr size_t WS_WUKV = WS_WUQ + 768 * 256 * 2;
constexpr size_t WS_WEV = 5 * MiB;
constexpr size_t WS_WO = 9 * MiB;
constexpr size_t WS_WOD = 13 * MiB;
constexpr size_t WS_WFI = 19 * MiB;
constexpr size_t WS_WFO = 41 * MiB;
constexpr size_t WS_XR16 = 53 * MiB;
constexpr size_t WS_XN = 125 * MiB;
constexpr size_t WS_KVRAW = WS_XN;
constexpr size_t WS_Y = 197 * MiB;
constexpr size_t WS_REG = 269 * MiB;
constexpr size_t WS_QRAW = WS_REG + 144 * MiB;
constexpr size_t WS_SHW = 485 * MiB;
constexpr size_t SHW_F0 = 0, SHW_OD = 17 * 5632 * 4, SHW_F1 = SHW_OD + 17 * 3072 * 4;
constexpr size_t WS_END = 487 * MiB;

constexpr int LDS_BYTES = 147456;
#define LAS __attribute__((address_space(3)))
typedef unsigned short bf16_t;
typedef unsigned u32x4 __attribute__((ext_vector_type(4)));
typedef unsigned u32x2 __attribute__((ext_vector_type(2)));
typedef float f32x4 __attribute__((ext_vector_type(4)));
typedef float f32x16 __attribute__((ext_vector_type(16)));
typedef short bf16x8 __attribute__((ext_vector_type(8)));
typedef short s16x4 __attribute__((ext_vector_type(4)));
using pg8::cvtpk;

struct Params {
    const float* in[30];
    float* out; unsigned char* ws;
    int ph_lo, ph_hi, abl, pad;
};
struct Frame {
    LAS unsigned char* lds;
    int tid, lane, wave, G, bid, abl;
    float* out; unsigned char* ws;
};
__device__ __forceinline__ const float* inptr(const Params& p, int i) { asm volatile("" : "+s"(i)); return p.in[i]; }
#define INP(i) inptr(p, (i))
#define IN_X 0
#define IN_C 1
#define IN_CTX 2
#define IN_CCTX 3
#define IN_MODW 4
#define IN_MODB 5
#define IN_NMIX 6
#define IN_NFFN 7
#define IN_WOUT 8
#define IN_FWIN 9
#define IN_FWOUT 10
#define IN_EVW 11
#define IN_DAQG 12
#define IN_DAKG 13
#define IN_LQ1 14
#define IN_LK1 15
#define IN_LQ2 16
#define IN_LK2 17
#define IN_DAOG 18
#define IN_MQAG 19
#define IN_WUQ 20
#define IN_MKVAG 21
#define IN_WUKV 22
#define IN_MQG 23
#define IN_MKG 24
#define IN_MKRG 25
#define IN_ODW 26
#define IN_NAQG 27
#define IN_NAKG 28
#define IN_RPB 29

__device__ __forceinline__ float wave_sum(float v) { return pg8::wave_sum_fast(v); }
__device__ __forceinline__ float bf_lo(unsigned w) { return __uint_as_float(w << 16); }
__device__ __forceinline__ float bf_hi(unsigned w) { return __uint_as_float(w & 0xffff0000u); }
__device__ __forceinline__ void unpack8(const u32x4 w, float (&v)[8]) { v[0] = bf_lo(w.x); v[1] = bf_hi(w.x); v[2] = bf_lo(w.y); v[3] = bf_hi(w.y); v[4] = bf_lo(w.z); v[5] = bf_hi(w.z); v[6] = bf_lo(w.w); v[7] = bf_hi(w.w); }
__device__ __forceinline__ u32x4 pack8(const float (&v)[8]) { u32x4 w; w.x = cvtpk(v[0], v[1]); w.y = cvtpk(v[2], v[3]); w.z = cvtpk(v[4], v[5]); w.w = cvtpk(v[6], v[7]); return w; }
#define LDS_WAIT() asm volatile("s_waitcnt lgkmcnt(0)" ::: "memory")

__device__ __forceinline__ void transpose_item(const float* W, int N, bf16_t* WT, int ldt, int dst_row, int k0, int n0, const float* kscale, LAS float* scr, int lane) {
#pragma unroll 8
    for (int i = 0; i < 32; ++i) { const int kk = 2 * i + (lane >> 5); float v = __builtin_nontemporal_load(W + (size_t)(k0 + kk) * N + n0 + (lane & 31));        if (kscale) v *= kscale[k0 + kk]; scr[kk * 33 + (lane & 31)] = v; }
    LDS_WAIT(); asm volatile("" ::: "memory");
    const int c = lane & 7;
#pragma unroll
    for (int j = 0; j < 4; ++j) { const int n = (lane >> 3) + 8 * j; const LAS float* s = scr + (8 * c) * 33 + n;
        u32x4 o; o.x = cvtpk(s[0 * 33], s[1 * 33]); o.y = cvtpk(s[2 * 33], s[3 * 33]); o.z = cvtpk(s[4 * 33], s[5 * 33]); o.w = cvtpk(s[6 * 33], s[7 * 33]);
        *(u32x4*)(WT + (size_t)(dst_row + n) * ldt + k0 + 8 * c) = o; }
    LDS_WAIT(); asm volatile("" ::: "memory");
}
__host__ __device__ __forceinline__ int head_row(int L) { return 256 * (L / 256) + 128 * ((L % 64) / 32) + 32 * ((L % 256) / 64); }
__device__ __forceinline__ void p0_prologue(Frame& F, const Params& p) {
    float* modv = (float*)(F.ws + WS_MODV);
    LAS float* condl = (LAS float*)F.lds;
    LAS float* red = (LAS float*)(F.lds + 17 * 1024 * 4);
    for (int e = F.tid; e < 17 * 1024; e += 512) { const int i = e >> 10, k = e & 1023; const float c = (i < 16) ? INP(IN_C)[i * 1024 + k] : INP(IN_CCTX)[k]; condl[e] = c / (1.0f + __expf(-c)); }
    __syncthreads();
    for (int item = F.bid; item < 256; item += F.G) {
        const int l = item >> 7, cg_ = item & 127, col = cg_ * 48 + (F.lane < 48 ? F.lane : 0);
        float acc[17];
#pragma unroll
        for (int i = 0; i < 17; ++i) acc[i] = 0.f;
        const float* wp = INP(IN_MODW) + ((size_t)l * 1024 + F.wave * 128) * 6144 + col;
        const LAS float* cl = condl + F.wave * 128;
#pragma unroll 8
        for (int k = 0; k < 128; ++k) { const float wv = __builtin_nontemporal_load(wp + (size_t)k * 6144);
#pragma unroll
            for (int i = 0; i < 17; ++i) acc[i] += cl[i * 1024 + k] * wv; }
        if (F.lane < 48) {
#pragma unroll
            for (int i = 0; i < 17; ++i) red[(F.wave * 17 + i) * 48 + F.lane] = acc[i]; }
        __syncthreads();
        for (int t = F.tid; t < 17 * 48; t += 512) { const int i = t / 48, cl2 = t % 48; float s = 0.f;
#pragma unroll
            for (int w = 0; w < 8; ++w) s += red[(w * 17 + i) * 48 + cl2];
            modv[((size_t)l * 17 + i) * 6144 + cg_ * 48 + cl2] = s + INP(IN_MODB)[l * 6144 + cg_ * 48 + cl2]; }
        __syncthreads();
    }
    { float* z = (float*)(F.ws + WS_SSQ); for (int e = F.bid * 512 + F.tid; e < (int)(5 * SSQ_STRIDE / 4); e += F.G * 512) z[e] = 0.f; }
    { const int gt = F.bid * 512 + F.tid; if (gt < 1024) { const int pos = gt >> 4, f = gt & 15; const float inv = __builtin_amdgcn_exp2f(-(float)f * 0.8304820237218405f);
          const float rev = (float)pos * inv * 0.15915494309189535f, fr = rev - floorf(rev);
          float* rt = (float*)(F.ws + WS_SMALL); rt[2 * gt] = __builtin_amdgcn_cosf(fr); rt[2 * gt + 1] = __builtin_amdgcn_sinf(fr); } }
    LAS float* scr = (LAS float*)(F.lds + F.wave * 16384);
    const int gw = F.bid * 8 + F.wave, NGW = F.G * 8;
    constexpr int I_EV = 16 * 62, I_O = 16 * 32, I_FI = 16 * 176, I_FO = 44 * 32, I_OD = 16 * 96, I_UQ = 4 * 24, I_UKV = 2 * 32;
    constexpr int NITEMS = I_EV + 2 * I_O + 2 * I_FI + 2 * I_FO + I_OD + I_UQ + I_UKV;
    for (int it = gw; it < NITEMS; it += NGW) {
        int r = it;
        if (r < I_EV) { const int kb = r / 62, nb = r % 62; transpose_item(INP(IN_EVW), EVN, (bf16_t*)(F.ws + WS_WEV), 1024, head_row(32 * nb), 64 * kb, 32 * nb, nullptr, scr, F.lane); continue; } r -= I_EV;
        if (r < 2 * I_O) { const int l = r / I_O; r %= I_O; const int kb = r / 32, nb = r % 32; transpose_item(INP(IN_WOUT) + (size_t)l * 1024 * 1024, 1024, (bf16_t*)(F.ws + WS_WO) + (size_t)l * 1024 * 1024, 1024, 32 * nb, 64 * kb, 32 * nb, nullptr, scr, F.lane); continue; } r -= 2 * I_O;
        if (r < 2 * I_FI) { const int l = r / I_FI; r %= I_FI; const int kb = r / 176, nb = r % 176; const int n0 = 32 * nb, up = n0 >= DFF ? 1 : 0, jj = n0 - up * DFF;
            const int drow = (jj / 128) * 256 + up * 128 + (jj % 128);
            transpose_item(INP(IN_FWIN) + (size_t)l * 1024 * 5632, 5632, (bf16_t*)(F.ws + WS_WFI) + (size_t)l * 5632 * 1024, 1024, drow, 64 * kb, n0, nullptr, scr, F.lane); continue; } r -= 2 * I_FI;
        if (r < 2 * I_FO) { const int l = r / I_FO; r %= I_FO; const int kb = r / 32, nb = r % 32; transpose_item(INP(IN_FWOUT) + (size_t)l * DFF * 1024, 1024, (bf16_t*)(F.ws + WS_WFO + (size_t)l * 6 * MiB), DFF, 32 * nb, 64 * kb, 32 * nb, nullptr, scr, F.lane); continue; } r -= 2 * I_FO;
        if (r < I_OD) { const int kb = r / 96, nb = r % 96; transpose_item(INP(IN_ODW), ODN, (bf16_t*)(F.ws + WS_WOD), 1024, head_row(32 * nb), 64 * kb, 32 * nb, nullptr, scr, F.lane); continue; } r -= I_OD;
        if (r < I_UQ) { const int kb = r / 24, nb = r % 24; transpose_item(INP(IN_WUQ), 768, (bf16_t*)(F.ws + WS_WUQ), 256, 32 * nb, 64 * kb, 32 * nb, INP(IN_MQAG), scr, F.lane); continue; } r -= I_UQ;
        { const int kb = r / 32, nb = r % 32; transpose_item(INP(IN_WUKV), 1024, (bf16_t*)(F.ws + WS_WUKV), 256, 32 * nb, 64 * kb, 32 * nb, INP(IN_MKVAG), scr, F.lane); }
    }
}

__device__ __forceinline__ void norm_pass(Frame& F, const Params& p, int layer, const float* gain, int ch_sh, int ch_sc, bool from_inputs, bool latent_only) {
    const float* modv = (const float*)(F.ws + WS_MODV) + (size_t)layer * 17 * 6144;
    bf16_t* XN = (bf16_t*)(F.ws + WS_XN);
    const int gw = F.bid * 8 + F.wave, NGW = F.G * 8;
    for (int chunk = gw; chunk < MROWS / 18; chunk += NGW) {
        int cur = -1; f32x4 gs[4], shv[4];
        for (int r0 = 0; r0 < 18; r0 += 3) {
            f32x4 v[3][4];
#pragma unroll
            for (int q = 0; q < 3; ++q) {
                const int R = chunk * 18 + r0 + q, b = R / TU, t = R % TU; const bool isc = t < CTXL;
                const float* src;
                if (from_inputs) src = isc ? INP(IN_CTX) + ((size_t)b * CTXL + t) * 1024 : INP(IN_X) + ((size_t)b * SEQ + (t - CTXL)) * 1024;
                else src = F.out + ((size_t)b * SEQ + (isc ? 0 : t - CTXL)) * 1024;
#pragma unroll
                for (int j = 0; j < 4; ++j) v[q][j] = __builtin_nontemporal_load((const f32x4*)(src + 256 * j + 4 * F.lane));
            }
#pragma unroll
            for (int q = 0; q < 3; ++q) {
                const int R = chunk * 18 + r0 + q, b = R / TU, t = R % TU; const bool isc = t < CTXL;
                if (latent_only && isc) continue;
                const int midx = isc ? 16 : b;
                if (midx != cur) { cur = midx; const float* mv = modv + (size_t)midx * 6144;
#pragma unroll
                    for (int j = 0; j < 4; ++j) { const f32x4 g4 = *(const f32x4*)(gain + 256 * j + 4 * F.lane), sc4 = *(const f32x4*)(mv + ch_sc * 1024 + 256 * j + 4 * F.lane);
                        gs[j] = g4 * (sc4 + 1.0f); shv[j] = *(const f32x4*)(mv + ch_sh * 1024 + 256 * j + 4 * F.lane); } }
                float ss = 0.f;
#pragma unroll
                for (int j = 0; j < 4; ++j) ss += (v[q][j].x * v[q][j].x + v[q][j].y * v[q][j].y) + (v[q][j].z * v[q][j].z + v[q][j].w * v[q][j].w);
                const float rstd = 1.0f / sqrtf(wave_sum(ss) * (1.0f / 1024.0f) + EPS);
#pragma unroll
                for (int j = 0; j < 4; ++j) { const f32x4 h = v[q][j] * rstd * gs[j] + shv[j]; u32x2 w; w.x = cvtpk(h.x, h.y); w.y = cvtpk(h.z, h.w);
                    *(u32x2*)(XN + (size_t)R * 1024 + 256 * j + 4 * F.lane) = w; }
            }
        }
    }
}

__device__ __forceinline__ void shw_pass(Frame& F) {
    const float* modv = (const float*)(F.ws + WS_MODV);
    const int gw = F.bid * 8 + F.wave, NGW = F.G * 8, lane = F.lane;
    for (int it = gw; it < 5632 + 3072 + 5632; it += NGW) {
        const bf16_t* wt; const float* sh; float* dst; int n, ld;
        if (it < 5632) { n = it; wt = (const bf16_t*)(F.ws + WS_WFI); sh = modv + 3 * 1024; dst = (float*)(F.ws + WS_SHW + SHW_F0); ld = 5632; }
        else if (it < 5632 + 3072) { n = it - 5632; wt = (const bf16_t*)(F.ws + WS_WOD); sh = modv + 17 * 6144; dst = (float*)(F.ws + WS_SHW + SHW_OD); ld = 3072; }
        else { n = it - 5632 - 3072; wt = (const bf16_t*)(F.ws + WS_WFI) + (size_t)5632 * 1024; sh = modv + 17 * 6144 + 3 * 1024; dst = (float*)(F.ws + WS_SHW + SHW_F1); ld = 5632; }
        float wv[16]; { float a[8], b2[8]; unpack8(*(const u32x4*)(wt + (size_t)n * 1024 + 16 * lane), a); unpack8(*(const u32x4*)(wt + (size_t)n * 1024 + 16 * lane + 8), b2);
#pragma unroll
            for (int e = 0; e < 8; ++e) { wv[e] = a[e]; wv[8 + e] = b2[e]; } }
        float acc[17];
#pragma unroll
        for (int i = 0; i < 17; ++i) { const float* sp = sh + (size_t)i * 6144 + 16 * lane; float s2 = 0.f;
#pragma unroll
            for (int q = 0; q < 4; ++q) { const f32x4 x = *(const f32x4*)(sp + 4 * q); s2 += (x[0] * wv[4 * q] + x[1] * wv[4 * q + 1]) + (x[2] * wv[4 * q + 2] + x[3] * wv[4 * q + 3]); }
            acc[i] = s2; }
        { const bool b5 = (lane & 32) != 0, b4 = (lane & 16) != 0, b3 = (lane & 8) != 0, b2 = (lane & 4) != 0;
          float w8[8], w4[4], w2[2], z;
#pragma unroll
          for (int q = 0; q < 8; ++q) { const float snd = b5 ? acc[q] : acc[8 + q], kp = b5 ? acc[8 + q] : acc[q]; w8[q] = kp + __shfl_xor(snd, 32); }
#pragma unroll
          for (int q = 0; q < 4; ++q) { const float snd = b4 ? w8[q] : w8[4 + q], kp = b4 ? w8[4 + q] : w8[q]; w4[q] = kp + __shfl_xor(snd, 16); }
#pragma unroll
          for (int q = 0; q < 2; ++q) { const float snd = b3 ? w4[q] : w4[2 + q], kp = b3 ? w4[2 + q] : w4[q]; w2[q] = kp + __shfl_xor(snd, 8); }
          { const float snd = b2 ? w2[0] : w2[1], kp = b2 ? w2[1] : w2[0]; z = kp + __shfl_xor(snd, 4); }
          z += __shfl_xor(z, 2); z += __shfl_xor(z, 1);
          const int idx = (b5 ? 8 : 0) + (b4 ? 4 : 0) + (b3 ? 2 : 0) + (b2 ? 1 : 0);
          if ((lane & 3) == 0) dst[(size_t)idx * ld + n] = z;
          const float s16 = wave_sum(acc[16]); if (lane == 0) dst[(size_t)16 * ld + n] = s16; }
    }
}

__device__ __forceinline__ void group64_norm(float (&v)[8], const float* gain, bool rope, int prow, int pcol, const float* ropet, float oscale, int lane) {
    float ss = 0.f;
#pragma unroll
    for (int e = 0; e < 8; ++e) ss += v[e] * v[e];
    ss += __shfl_xor(ss, 1); ss += __shfl_xor(ss, 2); ss += __shfl_xor(ss, 4);
    const float rstd = 1.0f / sqrtf(ss * (1.0f / 64.0f) + EPS);
    const int u = lane & 7;
#pragma unroll
    for (int e = 0; e < 8; ++e) v[e] *= rstd * gain[8 * u + e];
    float pv[8];
#pragma unroll
    for (int e = 0; e < 8; ++e) pv[e] = __shfl_xor(v[e], 2);
    if (rope) { const int pos = (u & 4) ? pcol : prow; const float* rt = ropet + (pos * 16 + 8 * (u & 1)) * 2;
#pragma unroll
        for (int e = 0; e < 8; ++e) { const float cs = rt[2 * e], sn = rt[2 * e + 1]; v[e] = (u & 2) ? (pv[e] * sn + v[e] * cs) : (v[e] * cs - pv[e] * sn); } }
#pragma unroll
    for (int e = 0; e < 8; ++e) v[e] *= oscale;
}
__device__ __forceinline__ void post_proj0(Frame& F, const Params& p) {
    bf16_t* PROJ = (bf16_t*)(F.ws + WS_REG);
    const float* ropet = (const float*)(F.ws + WS_SMALL);
    float* rcq = (float*)(F.ws + WS_SMALL + 65536); float* rckv = (float*)(F.ws + WS_SMALL + 262144);
    const int gw = F.bid * 8 + F.wave, NGW = F.G * 8, lane = F.lane;
    for (int chunk = gw; chunk < MROWS / 18; chunk += NGW)
        for (int r = 0; r < 18; ++r) {
            const int R = chunk * 18 + r, t = R % TU; const bool lat = t >= CTXL; const int tl = lat ? t - CTXL : 0, prow = tl >> 6, pcol = tl & 63;
            bf16_t* rowp = PROJ + (size_t)R * 2048;
#pragma unroll
            for (int ci = 0; ci < 2; ++ci) { float v[8]; unpack8(*(const u32x4*)(rowp + 512 * ci + 8 * lane), v);
                group64_norm(v, ci == 0 ? INP(IN_DAQG) : INP(IN_DAKG), lat, prow, pcol, ropet, ci == 0 ? QS_DA : 1.0f, lane);
                *(u32x4*)(rowp + 512 * ci + 8 * lane) = pack8(v); }
            { float v[8]; unpack8(*(const u32x4*)(rowp + 1536 + 8 * lane), v);
              float ss = 0.f;
#pragma unroll
              for (int e = 0; e < 8; ++e) ss += v[e] * v[e];
              ss += __shfl_xor(ss, 1); ss += __shfl_xor(ss, 2); ss += __shfl_xor(ss, 4);
              const float s8 = ss; const float s16 = s8 + __shfl_xor(s8, 8); const float s32 = s16 + __shfl_xor(s16, 16);
              if (lane == 0) rcq[R] = 1.0f / sqrtf(s32 * (1.0f / 256.0f) + EPS);
              if (lane == 32) rckv[R] = 1.0f / sqrtf(s16 * (1.0f / 128.0f) + EPS);
              group64_norm(v, INP(IN_MKRG), lat, prow, pcol, ropet, 1.0f, lane);
              if (lane >= 48 && lane < 56) *(u32x4*)(rowp + 1536 + 8 * lane) = pack8(v); }
        }
}
__device__ __forceinline__ void post_up0(Frame& F, const Params& p) {
    bf16_t* KVRAW = (bf16_t*)(F.ws + WS_KVRAW);
    const int gw = F.bid * 8 + F.wave, NGW = F.G * 8, lane = F.lane, l32 = lane & 31, head = l32 >> 3, sub = l32 & 7;
    const float* g = INP(IN_MKG) + 16 * sub;
    float gn[16];
#pragma unroll
    for (int e = 0; e < 16; ++e) gn[e] = g[e];
    for (int chunk = gw; chunk < MROWS / 18; chunk += NGW)
        for (int r0 = 0; r0 < 18; r0 += 6) {
            u32x4 ra[3], rb[3];
#pragma unroll
            for (int q = 0; q < 3; ++q) { const int R = chunk * 18 + r0 + 2 * q + (lane >> 5); const bf16_t* rowp = KVRAW + (size_t)R * 1024 + 256 * head + 16 * sub;
                ra[q] = *(const u32x4*)(rowp); rb[q] = *(const u32x4*)(rowp + 8); }
#pragma unroll
            for (int q = 0; q < 3; ++q) { const int R = chunk * 18 + r0 + 2 * q + (lane >> 5); bf16_t* rowp = KVRAW + (size_t)R * 1024 + 256 * head + 16 * sub;
                float a[8], b[8]; unpack8(ra[q], a); unpack8(rb[q], b);
                float ss = 0.f;
#pragma unroll
                for (int e = 0; e < 8; ++e) ss += a[e] * a[e] + b[e] * b[e];
                ss += __shfl_xor(ss, 1); ss += __shfl_xor(ss, 2); ss += __shfl_xor(ss, 4);
                const float rn = 1.0f / sqrtf(ss * (1.0f / 128.0f) + EPS);
#pragma unroll
                for (int e = 0; e < 8; ++e) { a[e] *= rn * gn[e]; b[e] *= rn * gn[8 + e]; }
                *(u32x4*)(rowp) = pack8(a); *(u32x4*)(rowp + 8) = pack8(b); }
        }
}
__device__ __forceinline__ void post_proj1(Frame& F, const Params& p) {
    bf16_t* P1 = (bf16_t*)(F.ws + WS_REG);
    const int gw = F.bid * 8 + F.wave, NGW = F.G * 8, lane = F.lane;
    for (int chunk = gw; chunk < MROWS / 18; chunk += NGW)
        for (int r = 0; r < 18; ++r) {
            const int R = chunk * 18 + r; bf16_t* rowp = P1 + (size_t)R * ODN;
#pragma unroll
            for (int ci = 0; ci < 4; ++ci) { float v[8]; unpack8(*(const u32x4*)(rowp + 512 * ci + 8 * lane), v);
                group64_norm(v, ci < 2 ? INP(IN_NAQG) : INP(IN_NAKG), false, 0, 0, nullptr, ci < 2 ? QS_NA : 1.0f, lane);
                *(u32x4*)(rowp + 512 * ci + 8 * lane) = pack8(v); }
        }
}

#ifndef USE_TR
#define USE_TR 1
#endif
template <int MODE> struct ACfg;
template <> struct ACfg<0> { static constexpr int DQK = 192, DV = 128, NKROWS = 64; };
template <> struct ACfg<1> { static constexpr int DQK = 64, DV = 128, NKROWS = 128; };
template <> struct ACfg<2> { static constexpr int DQK = 64, DV = 64, NKROWS = 64; };
__device__ __forceinline__ int crow(int r, int hi) { return (r & 3) + 8 * (r >> 2) + 4 * hi; }
__device__ __forceinline__ bf16x8 pack8f(float a0, float a1, float a2, float a3, float a4, float a5, float a6, float a7) {
    u32x4 w; w.x = cvtpk(a0, a1); w.y = cvtpk(a2, a3); w.z = cvtpk(a4, a5); w.w = cvtpk(a6, a7); return __builtin_bit_cast(bf16x8, w); }
typedef short v4i16_t __attribute__((ext_vector_type(4)));

struct AttnArgs {
    const bf16_t* q; int q_pitch;
    const bf16_t* kA; int kA_pitch;
    const bf16_t* kB; int kB_pitch;
    const bf16_t* v; int v_pitch;
    int nt;
    int klo;
    int r0;
    const float* qg; const float* ropet; int qt0;
};

__device__ __forceinline__ void glds16(const void* gsrc, unsigned lds_dst) { unsigned keep;
    asm volatile("s_mov_b32 %0, m0\n\ts_mov_b32 m0, %2\n\ts_nop 0\n\tglobal_load_lds_dwordx4 %1, off\n\ts_mov_b32 m0, %0" : "=&s"(keep) : "v"(gsrc), "s"(lds_dst) : "memory"); }
__device__ __forceinline__ float max3f(float a, float b, float c) { float r; asm("v_max3_f32 %0, %1, %2, %3" : "=v"(r) : "v"(a), "v"(b), "v"(c)); return r; }
__device__ __forceinline__ float max2f(float a, float b) { float r; asm("v_max_f32_e32 %0, %1, %2" : "=v"(r) : "v"(a), "v"(b)); return r; }
template <int MODE, int ABL = 0, bool XS = false>
__device__ __forceinline__ void attn_core(LAS unsigned char* lds, const AttnArgs& A, f32x16 (&o)[ACfg<MODE>::DV / 32], float& linv, const LAS float* rpbl, bf16x8 (&qf)[ACfg<MODE>::DQK / 16], bool pre = false, bool has_next = false) {
    constexpr int DQK = ACfg<MODE>::DQK, DV = ACfg<MODE>::DV;
    constexpr int NIMG = (MODE == 0) ? 3 : (MODE == 1 ? 2 : 1), KBYTES = NIMG * 8192, VBYTES = 64 * DV * 2, STG = KBYTES + VBYTES, KPT = NIMG, VPT = DV / 64, PT = KPT + VPT;
    constexpr int DIST = (MODE == 2) ? 3 : 2, NSLOT = DIST + 1;
    static_assert(NSLOT * STG <= 131072, "attention tile geometry");
    const int tid = threadIdx.x, lane = tid & 63, r32 = lane & 31, hi = lane >> 5, w = __builtin_amdgcn_readfirstlane(tid >> 6);
    const int comp = (MODE == 1) ? (w >> 2) : 0, grp = (MODE == 2) ? 0 : (w >> 2);
    int qrow_idx; int rs_w = 0, rq = 0, cq = 0;
    if (MODE == 0) qrow_idx = 32 * w + r32;
    else if (MODE == 1) qrow_idx = 32 * (w & 3) + r32;
    else { rq = A.r0 + (w >> 1); cq = 32 * (w & 1) + r32; qrow_idx = (w >> 1) * 64 + cq; rs_w = rq - 4 < 0 ? 0 : (rq - 4 > 24 ? 24 : rq - 4); }
    const bf16_t* qrow = A.q + (size_t)qrow_idx * A.q_pitch + (MODE == 1 ? 64 * comp : 0);
#pragma unroll
    for (int d = 0; d < DV / 32; ++d) o[d] = (f32x16){0.f, 0.f, 0.f, 0.f, 0.f, 0.f, 0.f, 0.f, 0.f, 0.f, 0.f, 0.f, 0.f, 0.f, 0.f, 0.f};
    float lsum = 0.f;
    const int cs_q = (MODE == 2) ? (cq - 8 < 0 ? 0 : (cq - 8 > 48 ? 48 : cq - 8)) : 0;
    unsigned vm0 = 0u, vm1 = 0u;
    if (MODE == 2) {
#pragma unroll
        for (int r = 0; r < 16; ++r) { const int kc = crow(r, hi); vm0 |= ((unsigned)(kc - cs_q) < 16u ? 1u : 0u) << r; vm1 |= ((unsigned)(kc + 32 - cs_q) < 16u ? 1u : 0u) << r; } }
    unsigned koff[KPT], voff[VPT];
    { const int row = 8 * w + (lane >> 3), sc = (lane & 7) ^ ((row >> 1) & 7);
#pragma unroll
      for (int i = 0; i < KPT; ++i) {
        if (MODE == 0) koff[i] = (i < 2) ? (unsigned)(row * A.kA_pitch + 64 * i + sc * 8) * 2u : (unsigned)(row * A.kB_pitch + sc * 8) * 2u;
        else koff[i] = (unsigned)(row * A.kA_pitch + sc * 8) * 2u;
      } }
#pragma unroll
    for (int i = 0; i < VPT; ++i) { const int pc = w + 8 * i, dblk = pc >> 2, rg = pc & 3; voff[i] = (unsigned)((16 * rg + (lane >> 2)) * A.v_pitch + 32 * dblk + (lane & 3) * 8) * 2u; }
#define TILE_T0(tile) ((MODE == 2) ? ((tile) < 4 ? 64 * (tile) : CTXL + 64 * (A.klo + (tile) - 4)) : 64 * (tile))
#define DMA_TILE(tile, slotoff) do { const int t0_ = TILE_T0(tile); \
        const char* kAb_ = (const char*)A.kA + (size_t)t0_ * A.kA_pitch * 2; const char* kBb_ = (const char*)A.kB + (size_t)t0_ * A.kB_pitch * 2; const char* vb_ = (const char*)A.v + (size_t)t0_ * A.v_pitch * 2; \
        _Pragma("unroll") for (int i = 0; i < KPT; ++i) { const char* b_ = (MODE == 0) ? (i < 2 ? kAb_ : kBb_) : ((MODE == 1 && i == 1) ? kBb_ : kAb_); \
            glds16(b_ + koff[i], (unsigned)__builtin_amdgcn_readfirstlane((int)(lds0 + (unsigned)((slotoff) + i * 8192 + w * 1024)))); } \
        _Pragma("unroll") for (int i = 0; i < VPT; ++i) \
            glds16(vb_ + voff[i], (unsigned)__builtin_amdgcn_readfirstlane((int)(lds0 + (unsigned)((slotoff) + KBYTES + (w + 8 * i) * 1024)))); } while (0)
#define WAITV(n) asm volatile("s_waitcnt vmcnt(" #n ")" ::: "memory")
#define WAIT_TILE(more) do { if (more) { if (PT == 2) WAITV(2); else if (PT == 4) WAITV(4); else WAITV(5); } else WAITV(0); } while (0)
#define WAIT_TILE2(newer) do { if ((newer) >= 2) { if (PT == 2) WAITV(4); else if (PT == 4) WAITV(8); else WAITV(10); } else WAIT_TILE((newer) >= 1); } while (0)
#define BAR() do { __builtin_amdgcn_s_barrier(); asm volatile("" ::: "memory"); } while (0)
    const unsigned lds0 = (unsigned)(uintptr_t)lds;
    int s_cur = 0, s_n1 = STG, s_n2 = 2 * STG, s_n3 = 3 * STG;
    if (XS && pre) { WAITV(8);
#pragma unroll
        for (int s = 0; s < DQK / 16; ++s) asm volatile("" : "+v"(qf[s]));
    } else {
    DMA_TILE(0, 0);
    if (A.nt > 1) DMA_TILE(1, STG);
    if (DIST > 2 && A.nt > 2) DMA_TILE(2, 2 * STG);
#pragma unroll
    for (int s = 0; s < DQK / 16; ++s) qf[s] = *(const bf16x8*)(qrow + 16 * s + 8 * hi);
    WAITV(0);
#pragma unroll
    for (int s = 0; s < DQK / 16; ++s) asm volatile("" : "+v"(qf[s]));
    }
#pragma unroll
    for (int s = 0; s < DQK / 16; ++s) asm volatile("" : "+v"(qf[s]));
    if (MODE == 0) {
        float ss = 0.f;
#pragma unroll
        for (int s = 0; s < DQK / 16; ++s) { float v[8]; unpack8(__builtin_bit_cast(u32x4, qf[s]), v);
#pragma unroll
            for (int j = 0; j < 8; ++j) ss += v[j] * v[j]; }
        ss = pg8::sum_xor32(ss);
        const float rn = QS_MLA / sqrtf(ss * (1.0f / 192.0f) + EPS);
        const int tq = A.qt0 + qrow_idx; const bool lat = tq >= CTXL; const int tl = lat ? tq - CTXL : 0;
#pragma unroll
        for (int s = 0; s < 8; ++s) { float v[8]; unpack8(__builtin_bit_cast(u32x4, qf[s]), v);
            const f32x4 g0 = *(const f32x4*)(A.qg + 16 * s + 8 * hi), g1 = *(const f32x4*)(A.qg + 16 * s + 8 * hi + 4);
            v[0] *= rn * g0[0]; v[1] *= rn * g0[1]; v[2] *= rn * g0[2]; v[3] *= rn * g0[3]; v[4] *= rn * g1[0]; v[5] *= rn * g1[1]; v[6] *= rn * g1[2]; v[7] *= rn * g1[3];
            qf[s] = __builtin_bit_cast(bf16x8, pack8(v)); asm volatile("" : "+v"(qf[s])); }
#pragma unroll
        for (int h2 = 0; h2 < 2; ++h2) {
            float x1[8], x2[8]; unpack8(__builtin_bit_cast(u32x4, qf[8 + 2 * h2]), x1); unpack8(__builtin_bit_cast(u32x4, qf[9 + 2 * h2]), x2);
            const float* ga = A.qg + 16 * (8 + 2 * h2) + 8 * hi; const float* gb = ga + 16;
            const float* rt = A.ropet + (((h2 == 0) ? (tl >> 6) : (tl & 63)) * 16 + 8 * hi) * 2;
#pragma unroll
            for (int j = 0; j < 8; ++j) { const float a1 = x1[j] * rn * ga[j], a2 = x2[j] * rn * gb[j]; const float cs = lat ? rt[2 * j] : 1.0f, sn = lat ? rt[2 * j + 1] : 0.0f;
                x1[j] = a1 * cs - a2 * sn; x2[j] = a1 * sn + a2 * cs; }
            qf[8 + 2 * h2] = __builtin_bit_cast(bf16x8, pack8(x1)); qf[9 + 2 * h2] = __builtin_bit_cast(bf16x8, pack8(x2));
            asm volatile("" : "+v"(qf[8 + 2 * h2]), "+v"(qf[9 + 2 * h2])); }
    }
    if (grp == 1) { WAIT_TILE(A.nt > 1); BAR(); }
    const int vlane = ((lane >> 4) & 1) * 32 + (lane & 3) * 8 + (4 * hi + ((lane & 15) >> 2)) * 64;
    int kx[4];
#pragma unroll
    for (int q = 0; q < 4; ++q) kx[q] = r32 * 128 + (((2 * q + hi) ^ ((r32 >> 1) & 7)) << 4);
#pragma nounroll
    for (int t = 0; t < A.nt; ++t) {
        if (grp == 0) { if (DIST == 3) WAIT_TILE2(A.nt - 1 - t); else WAIT_TILE(t + 1 < A.nt); }
        BAR();
        if (MODE == 2) { if (t + DIST < A.nt) DMA_TILE(t + DIST, s_n3); } else if (grp == 1 && t + 2 < A.nt) DMA_TILE(t + 2, s_n2);
        bool active = true; int kr = 0; const bool namask = (MODE == 2) && (t >= 4);
        if (MODE == 2 && t >= 4) { kr = A.klo + t - 4; active = (kr >= rs_w) && (kr <= rs_w + 7); }
        if (ABL == 1) active = false;
        const LAS unsigned char* kb = lds + s_cur + (MODE == 1 ? comp * 8192 : 0);
        const LAS unsigned char* vb = lds + s_cur + KBYTES + vlane;
        f32x16 p0 = (f32x16){0.f, 0.f, 0.f, 0.f, 0.f, 0.f, 0.f, 0.f, 0.f, 0.f, 0.f, 0.f, 0.f, 0.f, 0.f, 0.f}, p1 = p0;
        if (MODE == 2) {
            const LAS float* bl = rpbl + ((t >= 4) ? (kr - rq + 7) : 15) * 128 + (4 * hi - cq + 63);
#pragma unroll
            for (int r = 0; r < 16; ++r) { p0[r] = bl[(r & 3) + 8 * (r >> 2)]; p1[r] = bl[32 + (r & 3) + 8 * (r >> 2)]; }
        }
        bf16x8 pf[4];
        v4i16_t va[8], vb2[8];
#define SB() __builtin_amdgcn_sched_barrier(0)
#define KFRAG(s_, half_) (*(const LAS bf16x8*)(kb + ((s_) >> 2) * 8192 + kx[(s_) & 3] + (half_) * 4096))
#define KREAD(dst, b) do { dst[0] = KFRAG(2 * (b), 0); dst[1] = KFRAG(2 * (b), 1); dst[2] = KFRAG(2 * (b) + 1, 0); dst[3] = KFRAG(2 * (b) + 1, 1); } while (0)
#define KMMA(src, b) do { p0 = __builtin_amdgcn_mfma_f32_32x32x16_bf16(src[0], qf[2 * (b)], p0, 0, 0, 0); p1 = __builtin_amdgcn_mfma_f32_32x32x16_bf16(src[1], qf[2 * (b)], p1, 0, 0, 0); \
                          p0 = __builtin_amdgcn_mfma_f32_32x32x16_bf16(src[2], qf[2 * (b) + 1], p0, 0, 0, 0); p1 = __builtin_amdgcn_mfma_f32_32x32x16_bf16(src[3], qf[2 * (b) + 1], p1, 0, 0, 0); } while (0)
#define VREAD(dst, d) do { _Pragma("unroll") for (int ks_ = 0; ks_ < 4; ++ks_) { dst[2 * ks_] = __builtin_amdgcn_ds_read_tr16_b64_v4i16((LAS v4i16_t*)(vb + (d) * 4096 + ks_ * 1024)); \
                                                                             dst[2 * ks_ + 1] = __builtin_amdgcn_ds_read_tr16_b64_v4i16((LAS v4i16_t*)(vb + (d) * 4096 + ks_ * 1024 + 512)); } } while (0)
#define VMMA(src, d) do { _Pragma("unroll") for (int ks_ = 0; ks_ < 4; ++ks_) { const bf16x8 vf_ = (bf16x8){src[2 * ks_][0], src[2 * ks_][1], src[2 * ks_][2], src[2 * ks_][3], src[2 * ks_ + 1][0], src[2 * ks_ + 1][1], src[2 * ks_ + 1][2], src[2 * ks_ + 1][3]}; \
                              o[d] = __builtin_amdgcn_mfma_f32_32x32x16_bf16(vf_, pf[ks_], o[d], 0, 0, 0); } } while (0)
        if (active) {
            bf16x8 fa[4], fb[4];
            constexpr int NB = DQK / 32;
            KREAD(fa, 0);
#pragma unroll
            for (int b = 0; b < NB; b += 2) {
                KREAD(fb, b + 1); SB(); KMMA(fa, b); SB();
                if (b + 2 < NB) KREAD(fa, b + 2);
                SB(); KMMA(fb, b + 1); SB();
            }
            if (ABL == 3) { asm volatile("" :: "v"(p0), "v"(p1)); } else {
            SB();
            float rsum = 0.f;
#define EXPPACK(ks_, P, base) do { float e_[8]; _Pragma("unroll") for (int j_ = 0; j_ < 8; ++j_) { e_[j_] = __builtin_amdgcn_exp2f(P[(base) + j_]); \
                    if (MODE == 2 && namask) e_[j_] = __uint_as_float(__float_as_uint(e_[j_]) & (unsigned)__builtin_amdgcn_sbfe((int)((ks_) < 2 ? vm0 : vm1), (base) + j_, 1)); } \
                rsum += ((e_[0] + e_[1]) + (e_[2] + e_[3])) + ((e_[4] + e_[5]) + (e_[6] + e_[7])); pf[ks_] = pack8f(e_[0], e_[1], e_[2], e_[3], e_[4], e_[5], e_[6], e_[7]); SB(); } while (0)
            EXPPACK(0, p0, 0); EXPPACK(1, p0, 8); EXPPACK(2, p1, 0); EXPPACK(3, p1, 8);
#undef EXPPACK
            lsum += rsum;
            }
        }
        if (grp == 1 && t + 1 < A.nt) WAIT_TILE(t + 2 < A.nt);
        if (MODE != 2) BAR();
        if (MODE != 2 && grp == 0 && t + 2 < A.nt) DMA_TILE(t + 2, s_n2);
        if (active && ABL != 3) {
            if (ABL == 2) { asm volatile("" :: "v"(pf[0]), "v"(pf[1]), "v"(pf[2]), "v"(pf[3])); } else {
            constexpr int ND = DV / 32;
            VREAD(va, 0);
#pragma unroll
            for (int d = 0; d < ND; d += 2) {
                VREAD(vb2, d + 1); SB(); VMMA(va, d); SB();
                if (d + 2 < ND) VREAD(va, d + 2);
                SB(); VMMA(vb2, d + 1); SB();
            }
            }
        }
#undef SB
#undef KFRAG
#undef KREAD
#undef KMMA
#undef VREAD
#undef VMMA
        if (NSLOT == 4) { const int tmp = s_cur; s_cur = s_n1; s_n1 = s_n2; s_n2 = s_n3; s_n3 = tmp; } else { const int tmp = s_cur; s_cur = s_n1; s_n1 = s_n2; s_n2 = tmp; }
    }
    if (MODE != 2 && grp == 0) BAR();
    BAR();
    if (XS && has_next) {
        DMA_TILE(0, 0); DMA_TILE(1, STG); DMA_TILE(2, 2 * STG);
        const bf16_t* qn = qrow + (size_t)256 * A.q_pitch;
#pragma unroll
        for (int s = 0; s < DQK / 16; ++s) qf[s] = *(const bf16x8*)(qn + 16 * s + 8 * hi);
    }
    const float l = pg8::sum_xor32(lsum);
    linv = 1.0f / l;
#undef TILE_T0
#undef DMA_TILE
#undef WAITV
#undef WAIT_TILE
#undef WAIT_TILE2
#undef BAR
}

template <int NDV>
__device__ __forceinline__ void store_o(const f32x16 (&o)[NDV], float sc, bf16_t* orow, int hi) {
#pragma unroll
    for (int d = 0; d < NDV; ++d)
#pragma unroll
        for (int g = 0; g < 4; ++g) { u32x2 wv; wv.x = cvtpk(o[d][4 * g] * sc, o[d][4 * g + 1] * sc); wv.y = cvtpk(o[d][4 * g + 2] * sc, o[d][4 * g + 3] * sc);
            *(u32x2*)(orow + 32 * d + 8 * g + 4 * hi) = wv; }
}

constexpr int DA_XBUF = 0;
constexpr int NA_RPB = 4 * (8192 + 8192);

template <int ABL = 0>
__device__ __forceinline__ void mla_unit(Frame& F, const Params& p, int b, int h, int qb) {
    const bf16_t* PROJ = (const bf16_t*)(F.ws + WS_REG); const bf16_t* QRAW = (const bf16_t*)(F.ws + WS_QRAW); const bf16_t* KVRAW = (const bf16_t*)(F.ws + WS_KVRAW);
    bf16_t* Y = (bf16_t*)(F.ws + WS_Y);
    const size_t R0 = (size_t)b * TU;
    AttnArgs A; A.q = QRAW + (R0 + 256 * qb) * 768 + 192 * h; A.q_pitch = 768;
    A.kA = KVRAW + R0 * 1024 + 256 * h; A.kA_pitch = 1024; A.kB = PROJ + R0 * 2048 + 1920; A.kB_pitch = 2048;
    A.v = KVRAW + R0 * 1024 + 256 * h + 128; A.v_pitch = 1024; A.nt = (qb == 0) ? 4 : 36; A.klo = 0; A.r0 = 0; A.qg = INP(IN_MQG); A.ropet = (const float*)(F.ws + WS_SMALL); A.qt0 = 256 * qb;
    f32x16 o[4]; float linv; bf16x8 qf[12];
    attn_core<0, ABL>(F.lds, A, o, linv, nullptr, qf);
    int lane_ = F.lane; asm volatile("" : "+v"(lane_));
    const int r32 = lane_ & 31, hi = lane_ >> 5;
    store_o<4>(o, linv, Y + (R0 + 256 * qb + 32 * F.wave + r32) * 1024 + 512 + 128 * h, hi);
}
template <int ABL = 0>
__device__ __forceinline__ void da_unit(Frame& F, const Params& p, int b, int h, int qb, float lam) {
    const bf16_t* PROJ = (const bf16_t*)(F.ws + WS_REG); bf16_t* Y = (bf16_t*)(F.ws + WS_Y);
    const size_t R0 = (size_t)b * TU;
    AttnArgs A; A.q = PROJ + (R0 + 128 * qb) * 2048 + 128 * h; A.q_pitch = 2048;
    A.kA = PROJ + R0 * 2048 + 512 + 128 * h; A.kA_pitch = 2048; A.kB = A.kA + 64; A.kB_pitch = 2048;
    A.v = PROJ + R0 * 2048 + 1024 + 128 * h; A.v_pitch = 2048; A.nt = (qb < 2) ? 4 : 36; A.klo = 0; A.r0 = 0; A.qg = nullptr; A.ropet = nullptr; A.qt0 = 0;
    f32x16 o[4]; float linv; bf16x8 qf[4];
    attn_core<1, ABL>(F.lds, A, o, linv, nullptr, qf);
    int lane_ = F.lane; asm volatile("" : "+v"(lane_));
    const int r32 = lane_ & 31, hi = lane_ >> 5, comp = F.wave >> 2;
    LAS float* xb = (LAS float*)(F.lds + DA_XBUF) + (F.wave & 3) * 4096;
    if (comp == 1) {
#pragma unroll
        for (int d = 0; d < 4; ++d)
#pragma unroll
            for (int r = 0; r < 16; ++r) xb[(d * 16 + r) * 64 + lane_] = o[d][r] * linv; }
    __syncthreads();
    if (comp == 0) {
        float ss = 0.f;
#pragma unroll
        for (int d = 0; d < 4; ++d) {
#pragma unroll
            for (int r = 0; r < 16; ++r) { const float v = o[d][r] * linv - lam * xb[(d * 16 + r) * 64 + lane_]; o[d][r] = v; ss += v * v; }
            __builtin_amdgcn_sched_barrier(0); }
        ss += __shfl_xor(ss, 32);
        const float sc = (1.0f - LAM_INIT0) / sqrtf(ss * (1.0f / 128.0f) + EPS);
        const float* og = INP(IN_DAOG);
#pragma unroll
        for (int d = 0; d < 4; ++d)
#pragma unroll
            for (int g = 0; g < 4; ++g) { const f32x4 gv = *(const f32x4*)(og + 32 * d + 8 * g + 4 * hi);
                o[d][4 * g] *= gv.x; o[d][4 * g + 1] *= gv.y; o[d][4 * g + 2] *= gv.z; o[d][4 * g + 3] *= gv.w; }
        store_o<4>(o, sc, Y + (R0 + 128 * qb + 32 * (F.wave & 3) + r32) * 1024 + 128 * h, hi);
    }
    __syncthreads();
}
template <int ABL = 0>
__device__ __forceinline__ void na_unit(Frame& F, const Params& p, int b, int h, int band, bf16x8 (&qf)[4]) {
    const bf16_t* P1 = (const bf16_t*)(F.ws + WS_REG); bf16_t* Y = (bf16_t*)(F.ws + WS_Y);
    const size_t R0 = (size_t)b * TU;
    const int r0 = 4 * band; const int klo = r0 - 4 < 0 ? 0 : (r0 - 4 > 24 ? 24 : r0 - 4); const int rs3 = r0 - 1 < 0 ? 0 : (r0 - 1 > 24 ? 24 : r0 - 1); const int khi = rs3 + 7;
    AttnArgs A; A.q = P1 + (R0 + CTXL + 64 * r0) * ODN + 64 * h; A.q_pitch = ODN;
    A.kA = P1 + R0 * ODN + 1024 + 64 * h; A.kA_pitch = ODN; A.kB = A.kA; A.kB_pitch = ODN;
    A.v = P1 + R0 * ODN + 2048 + 64 * h; A.v_pitch = ODN; A.nt = 4 + (khi - klo + 1); A.klo = klo; A.r0 = r0; A.qg = nullptr; A.ropet = nullptr; A.qt0 = 0;
    f32x16 o[2]; float linv;
    attn_core<2, ABL, true>(F.lds, A, o, linv, (const LAS float*)(F.lds + NA_RPB), qf, band > 0, band < 7);
    int lane_ = F.lane; asm volatile("" : "+v"(lane_));
    const int r32 = lane_ & 31, hi = lane_ >> 5;
    store_o<2>(o, linv, Y + (R0 + CTXL + 64 * (r0 + (F.wave >> 1)) + 32 * (F.wave & 1) + r32) * 1024 + 64 * h, hi);
}


#define RLX_AGENT __ATOMIC_RELAXED, __HIP_MEMORY_SCOPE_AGENT
#define XB_TMO      128
#define XB_XCNT(j)  (256  + 64 * (j))
#define XB_XSUB(j)  (1280 + 64 * (j))
#define XB_XGEN(j)  (2304 + 64 * (j))
#define XB_TOP      3328
#define XB_TOPGEN   3392
#define XCD_BAR_WORDS 3456
#define XB_SPIN_CAP (1u << 18)

__device__ __forceinline__ unsigned xb_ld(unsigned* p)              { return __hip_atomic_load(p, __ATOMIC_RELAXED, __HIP_MEMORY_SCOPE_AGENT); }
__device__ __forceinline__ unsigned xb_add(unsigned* p, unsigned v) { return __hip_atomic_fetch_add(p, v, __ATOMIC_RELAXED, __HIP_MEMORY_SCOPE_AGENT); }
__device__ __forceinline__ unsigned xb_xcc_id() { return (unsigned)__builtin_amdgcn_s_getreg((3 << 11) | 20) & 0xFu; }
#define XB_SPIN(cond, bar) do { unsigned _sp = 0; while (cond) { __builtin_amdgcn_s_sleep(1); \
    if ((++_sp & 255u) == 0u) { if (xb_ld(&(bar)[XB_TMO])) break; if (_sp > XB_SPIN_CAP) { atomicAdd(&(bar)[XB_TMO], 1u); break; } } } } while (0)

struct XcdBarrier {
    unsigned* bar; unsigned x;
    volatile LAS unsigned* st;
};

__device__ __forceinline__ XcdBarrier xcd_barrier_post(unsigned* bar, volatile LAS unsigned* st) {
    XcdBarrier b; b.bar = bar; b.x = xb_xcc_id(); b.st = st;
    if (threadIdx.x == 0) (void)xb_add(&bar[XB_XCNT(b.x)], 1u);
    return b;
}
__device__ __forceinline__ void xcd_barrier_complete(unsigned* bar, unsigned x, unsigned& nloc, unsigned& nx) {
    const unsigned G = gridDim.x * gridDim.y * gridDim.z;
    unsigned sum, cnt, mine, sp = 0u;
    for (;;) {
        sum = 0u; cnt = 0u; mine = 0u;
#pragma unroll
        for (unsigned j = 0; j < 16; ++j) { const unsigned c = xb_ld(&bar[XB_XCNT(j)]); sum += c; cnt += (c > 0u) ? 1u : 0u; mine = (j == x) ? c : mine; }
        if (sum == G) break;
        __builtin_amdgcn_s_sleep(1);
        if ((++sp & 255u) == 0u) { if (xb_ld(&bar[XB_TMO])) break; if (sp > XB_SPIN_CAP) { atomicAdd(&bar[XB_TMO], 1u); break; } }
    }
    nloc = mine > 0u ? mine : 1u; nx = cnt > 0u ? cnt : 1u;
}

__device__ __forceinline__ void xcd_barrier(const XcdBarrier& b) {
    asm volatile("s_waitcnt vmcnt(0)" ::: "memory");
    __syncthreads();
    if (threadIdx.x == 0) {
        unsigned* bar = b.bar;
        __builtin_amdgcn_s_waitcnt(0);
        unsigned nloc = b.st[0], nx = b.st[1];
        if (nloc == 0u) { xcd_barrier_complete(bar, b.x, nloc, nx); b.st[0] = nloc; b.st[1] = nx; }
        const unsigned old = xb_add(&bar[XB_XSUB(b.x)], 1u);
        const unsigned gen = old / nloc;
        if (old + 1u == (gen + 1u) * nloc) {
            __builtin_amdgcn_fence(__ATOMIC_RELEASE, "agent");
            asm volatile("s_waitcnt vmcnt(0)" ::: "memory");
            const unsigned og = xb_add(&bar[XB_TOP], 1u);
            const unsigned tg = og / nx;
            if (og + 1u == (tg + 1u) * nx) xb_add(&bar[XB_TOPGEN], 1u);
            else XB_SPIN(xb_ld(&bar[XB_TOPGEN]) == tg, bar);
            __builtin_amdgcn_fence(__ATOMIC_ACQUIRE, "agent");
            xb_add(&bar[XB_XGEN(b.x)], 1u);
            asm volatile("s_waitcnt vmcnt(0)" ::: "memory");
        } else {
            XB_SPIN(xb_ld(&bar[XB_XGEN(b.x)]) == gen, bar);
            __builtin_amdgcn_fence(__ATOMIC_ACQUIRE, "agent");
            asm volatile("s_waitcnt vmcnt(0)" ::: "memory");
        }
    }
    __syncthreads();
}

__device__ __forceinline__ void zero_state(Frame& F) {
    if (F.bid == 0) { unsigned* bar = (unsigned*)(F.ws + WS_CTL) + 4096; for (int i = F.tid; i < XCD_BAR_WORDS; i += 512) __hip_atomic_store(bar + i, 0u, __ATOMIC_RELAXED, __HIP_MEMORY_SCOPE_AGENT); }
    const pg8::u32x4 z = {0u, 0u, 0u, 0u};
    for (int e = F.bid * 512 + F.tid; e < 1024 * 16; e += F.G * 512) { const int row = e >> 4, c = e & 15; *(pg8::u32x4*)(F.ws + WS_WUKV + (size_t)row * 512 + 256 + c * 16) = z; }
    for (int e = F.bid * 512 + F.tid; e < 64 * 128; e += F.G * 512) { const int rr = e >> 7, c = e & 127; const int row = (rr < 32 ? 1888 : 1984) + rr; *(pg8::u32x4*)(F.ws + WS_WEV + (size_t)row * 2048 + c * 16) = z; }
}

constexpr int N_PHASES = 15;
__global__ void __launch_bounds__(512, 2) fwd_kernel(Params p) {
    extern __shared__ __attribute__((aligned(16))) unsigned char lds_raw[];
    Frame F;
    F.lds = (LAS unsigned char*)lds_raw;
    F.tid = threadIdx.x; F.lane = F.tid & 63; F.wave = __builtin_amdgcn_readfirstlane(F.tid >> 6); F.G = gridDim.x; F.bid = blockIdx.x;
    F.out = p.out; F.ws = p.ws; F.abl = p.abl;
    cg::grid_group grid = cg::this_grid();
    const int lo = p.ph_lo, hi_ = p.ph_hi;
    volatile LAS unsigned* xbst = (volatile LAS unsigned*)(F.lds + LDS_BYTES - 64);
    if (F.tid < 2) xbst[F.tid] = 0u;
    __syncthreads();
    XcdBarrier xbar; xbar.bar = (unsigned*)(F.ws + WS_CTL) + 4096; xbar.x = xb_xcc_id(); xbar.st = xbst;
    if (lo > 0 && F.tid == 0) (void)xb_add(&xbar.bar[XB_XCNT(xbar.x)], 1u);
#ifndef PH_MASK
#define PH_MASK 0x7fff
#endif
#define PH(k) (((PH_MASK >> (k)) & 1) && lo <= (k) && (k) < hi_)
#ifndef USE_XB
#define USE_XB 1
#endif
#define SEAM(k) do { if (PH(k) && PH((k) + 1)) { if (!USE_XB || (k) == 0) grid.sync(); else xcd_barrier(xbar); } } while (0)
    bf16_t* const XN = (bf16_t*)(F.ws + WS_XN); bf16_t* const Y = (bf16_t*)(F.ws + WS_Y);
    bf16_t* const REG = (bf16_t*)(F.ws + WS_REG);
    bf16_t* const XR16 = (bf16_t*)(F.ws + WS_XR16);
    const float* const modv = (const float*)(F.ws + WS_MODV);
    using pg8::Gemm; using pg8::StaticOrder; using pg8::LatentOrder; using pg8::EpiStore; using pg8::EpiRes; using pg8::EpiSwiGLU;

    const float* const ropet = (const float*)(F.ws + WS_SMALL);
#define SSQP(slot, k) ((float*)(F.ws + WS_SSQ + (size_t)((F.abl && (k) == hi_ - 1) ? 5 : (slot)) * SSQ_STRIDE))
    if (PH(0)) { p0_prologue(F, p); zero_state(F); }
    SEAM(0);
    if (lo == 0 && F.tid == 0) (void)xb_add(&xbar.bar[XB_XCNT(xbar.x)], 1u);
    if (PH(1)) { norm_pass(F, p, 0, INP(IN_NMIX), 0, 1, true, false); shw_pass(F); }
    SEAM(1);
    if (PH(2)) { Gemm g{XN, (const bf16_t*)(F.ws + WS_WEV), MROWS, EVNP, 1024, 1024}; StaticOrder S; S.init(MROWS, EVNP, F.G, F.bid);
        const float* gq = INP(IN_DAQG); const float* gk = INP(IN_DAKG); const float* gr = INP(IN_MKRG); float* const sq_cq = SSQP(0, 2); float* const sq_ckv = SSQP(1, 2);
        auto gf = [=](int g) -> pg8::ProjGroup { if (g < 8) return {1, gq, QS_DA, 1, nullptr}; if (g < 16) return {1, gk, 1.0f, 1, nullptr}; if (g < 24) return {0, nullptr, 1.0f, 0, nullptr};
            if (g < 28) return {2, nullptr, 1.0f, 0, sq_cq}; if (g < 30) return {2, nullptr, 1.0f, 0, sq_ckv}; if (g == 30) return {1, gr, 1.0f, 1, nullptr}; return {0, nullptr, 1.0f, 0, nullptr}; };
        pg8::EpiProj<false, decltype(gf)> E{REG, 2048, nullptr, nullptr, 0, ropet, gf};
        pg8::gemm_phase<pg8::EpiProj<false, decltype(gf)>, StaticOrder, true, true>(F.lds, g, S, E); }
    SEAM(2);
    if (PH(3)) {
        int kup = 256; asm volatile("" : "+s"(kup));
        Gemm g{REG, (const bf16_t*)(F.ws + WS_WUQ), MROWS, 1792, kup, 2048}; pg8::UpOrder S; S.init(MROWS, 1792, F.G, F.bid);
        pg8::EpiUp E{(bf16_t*)(F.ws + WS_QRAW), (bf16_t*)(F.ws + WS_KVRAW), (const float*)(F.ws + WS_SSQ), (const float*)(F.ws + WS_SSQ + SSQ_STRIDE)};
        pg8::gemm_phase<pg8::EpiUp, pg8::UpOrder, true, true>(F.lds, g, S, E);
    }
    SEAM(3);
    if (PH(4)) post_up0(F, p);
    SEAM(4);
    if (PH(5)) {
        float lam; { const float a = INP(IN_LQ1)[F.lane] * INP(IN_LK1)[F.lane], b2 = INP(IN_LQ2)[F.lane] * INP(IN_LK2)[F.lane]; lam = __expf(wave_sum(a)) - __expf(wave_sum(b2)) + LAM_INIT0; }
        const int xcd = F.bid & 7, slot = F.bid >> 3;
        if (F.G == 256) {
            for (int i = 0; i < 2; ++i) { const int g = xcd * 8 + 4 * i + (slot >> 3), qb = 1 + (slot & 7); mla_unit<0>(F, p, g >> 2, g & 3, qb); }
            for (int i = 0; i < 4; ++i) { const int g = xcd * 8 + 2 * i + (slot >> 4), qb = 2 + (slot & 15); da_unit<0>(F, p, g >> 2, g & 3, qb, lam); }
            if (F.bid < 128) { const int g = F.bid >> 1; da_unit<0>(F, p, g >> 2, g & 3, F.bid & 1, lam); }
            else if (F.bid < 192) { const int g = F.bid - 128; mla_unit<0>(F, p, g >> 2, g & 3, 0); }
        } else {
            for (int u = F.bid; u < 64 * 9; u += F.G) { const int g = u / 9, qb = u % 9; mla_unit<0>(F, p, g >> 2, g & 3, qb); }
            for (int u = F.bid; u < 64 * 18; u += F.G) { const int g = u / 18, qb = u % 18; da_unit<0>(F, p, g >> 2, g & 3, qb, lam); }
        }
    }
    SEAM(5);
    const int slot32 = F.bid >> 3, pos_of = slot32 >= 8 ? slot32 - 8 : 24 + slot32;
    if (PH(6)) { Gemm g{Y, (const bf16_t*)(F.ws + WS_WO), MROWS, 1024, 1024, 1024}; LatentOrder S; S.init(1024, F.G, F.bid);
        pg8::EpiRes3<true, false> E{INP(IN_X), INP(IN_CTX), XR16, F.out, modv, 2, XN, SSQP(2, 6), INP(IN_NFFN), modv, 4};
        pg8::gemm_phase<pg8::EpiRes3<true, false>, LatentOrder, true, true>(F.lds, g, S, E); }
    SEAM(6);
    if (PH(7)) {
        { Gemm g{Y, (const bf16_t*)(F.ws + WS_WO), MROWS, 1024, 1024, 1024}; pg8::XcdOrder S; S.init(F.bid, 1, 4, 0, slot32, 1, 8, 0, 8, 0);
          pg8::EpiRes3<true, false> E{INP(IN_X), INP(IN_CTX), XR16, F.out, modv, 2, XN, SSQP(2, 7), INP(IN_NFFN), modv, 4};
          pg8::gemm_phase<pg8::EpiRes3<true, false>, pg8::XcdOrder, true, true>(F.lds, g, S, E); }
        { Gemm g{XN, (const bf16_t*)(F.ws + WS_WFI), MROWS, 2 * DFF, 1024, 1024}; pg8::XcdOrder S; S.init(F.bid, 0, 22, 0, pos_of, 12, 8, 11, 24, 10);
          pg8::EpiSwiGLU2 E{REG, (const float*)(F.ws + WS_SSQ + 2 * SSQ_STRIDE), (const float*)(F.ws + WS_SHW + SHW_F0)};
          pg8::gemm_phase<pg8::EpiSwiGLU2, pg8::XcdOrder, true, true>(F.lds, g, S, E); }
    }
    SEAM(7);
    if (PH(8)) {
        { Gemm g{REG, (const bf16_t*)(F.ws + WS_WFO), MROWS, 1024, DFF, HIDP}; pg8::XcdOrder S; S.init(F.bid, 0, 4, 0, slot32, 2, 32, 2, 32, 2);
          pg8::EpiRes3<false, false> E{nullptr, nullptr, XR16, F.out, modv, 5, XN, SSQP(3, 8), INP(IN_NMIX) + 1024, modv + 17 * 6144, 1};
          pg8::gemm_phase<pg8::EpiRes3<false, false>, pg8::XcdOrder, true, true>(F.lds, g, S, E); }
        { Gemm g{XN, (const bf16_t*)(F.ws + WS_WFI), MROWS, 2 * DFF, 1024, 1024}; pg8::XcdOrder S; S.init(F.bid, 1, 22, 0, slot32, 2, 12, 1, 32, 1);
          pg8::EpiSwiGLU2 E{REG, (const float*)(F.ws + WS_SSQ + 2 * SSQ_STRIDE), (const float*)(F.ws + WS_SHW + SHW_F0)};
          pg8::gemm_phase<pg8::EpiSwiGLU2, pg8::XcdOrder, true, true>(F.lds, g, S, E); }
    }
    SEAM(8);
    if (PH(9)) {
        { Gemm g{REG, (const bf16_t*)(F.ws + WS_WFO), MROWS, 1024, DFF, HIDP}; pg8::XcdOrder S; S.init(F.bid, 1, 4, 0, slot32, 1, 8, 0, 8, 0);
          pg8::EpiRes3<false, false> E{nullptr, nullptr, XR16, F.out, modv, 5, XN, SSQP(3, 9), INP(IN_NMIX) + 1024, modv + 17 * 6144, 1};
          pg8::gemm_phase<pg8::EpiRes3<false, false>, pg8::XcdOrder, true, true>(F.lds, g, S, E); }
        { Gemm g{XN, (const bf16_t*)(F.ws + WS_WOD), MROWS, ODN, 1024, 1024}; pg8::XcdOrder S; S.init(F.bid, 0, 12, 0, pos_of, 7, 16, 6, 24, 4);
          const float* gq1 = INP(IN_NAQG); const float* gk1 = INP(IN_NAKG);
          auto gf_od = [=](int g) -> pg8::ProjGroup { if (g < 16) return {1, gq1, QS_NA, 0, nullptr}; if (g < 32) return {1, gk1, 1.0f, 0, nullptr}; return {0, nullptr, 1.0f, 0, nullptr}; };
          typedef pg8::EpiProj<true, decltype(gf_od)> EpiOd;
          EpiOd E{REG, ODN, (const float*)(F.ws + WS_SSQ + 3 * SSQ_STRIDE), (const float*)(F.ws + WS_SHW + SHW_OD), 3072, ropet, gf_od};
          pg8::gemm_phase<EpiOd, pg8::XcdOrder, true, true>(F.lds, g, S, E); }
    }
    SEAM(9);
    if (PH(10)) { Gemm g{XN, (const bf16_t*)(F.ws + WS_WOD), MROWS, ODN, 1024, 1024}; pg8::XcdOrder S; S.init(F.bid, 1, 8, 4, slot32, 1, 16, 0, 16, 0);
        const float* gq1 = INP(IN_NAQG); const float* gk1 = INP(IN_NAKG);
          auto gf_od = [=](int g) -> pg8::ProjGroup { if (g < 16) return {1, gq1, QS_NA, 0, nullptr}; if (g < 32) return {1, gk1, 1.0f, 0, nullptr}; return {0, nullptr, 1.0f, 0, nullptr}; };
          typedef pg8::EpiProj<true, decltype(gf_od)> EpiOd;
          EpiOd E{REG, ODN, (const float*)(F.ws + WS_SSQ + 3 * SSQ_STRIDE), (const float*)(F.ws + WS_SHW + SHW_OD), 3072, ropet, gf_od};
        pg8::gemm_phase<EpiOd, pg8::XcdOrder, true, true>(F.lds, g, S, E); }
    SEAM(10);
    if (PH(11)) {
        for (int pr = F.bid; pr < 256; pr += F.G) { const int b = pr >> 4, h = pr & 15;
            LAS float* rp = (LAS float*)(F.lds + NA_RPB);
            __syncthreads();
            for (int i = F.tid; i < 16 * 128; i += 512) { const int dr = i >> 7, jx = (i & 127) - 48; rp[i] = (dr < 15 && jx >= 0 && jx < 31) ? INP(IN_RPB)[h * 465 + dr * 31 + jx] * LOG2E : 0.f; }
            bf16x8 qf[4];
#pragma nounroll
            for (int band = 0; band < 8; ++band) na_unit<0>(F, p, b, h, band, qf); }
    }
    SEAM(11);
    if (PH(12)) { Gemm g{Y, (const bf16_t*)(F.ws + WS_WO) + 1024 * 1024, MROWS, 1024, 1024, 1024}; LatentOrder S; S.init(1024, F.G, F.bid);
        pg8::EpiRes3<false, false> E{nullptr, nullptr, XR16, F.out, modv + 17 * 6144, 2, XN, SSQP(4, 12), INP(IN_NFFN) + 1024, modv + 17 * 6144, 4};
        pg8::gemm_phase<pg8::EpiRes3<false, false>, LatentOrder, true, true>(F.lds, g, S, E); }
    SEAM(12);
    if (PH(13)) { Gemm g{XN, (const bf16_t*)(F.ws + WS_WFI) + (size_t)5632 * 1024, MROWS, 2 * DFF, 1024, 1024}; LatentOrder S; S.init(2 * DFF, F.G, F.bid);
        pg8::EpiSwiGLU2 E{REG, (const float*)(F.ws + WS_SSQ + 4 * SSQ_STRIDE), (const float*)(F.ws + WS_SHW + SHW_F1)};
        pg8::gemm_phase<pg8::EpiSwiGLU2, LatentOrder, true, true>(F.lds, g, S, E); }
    SEAM(13);
    if (PH(14)) { Gemm g{REG, (const bf16_t*)(F.ws + WS_WFO + 6 * MiB), MROWS, 1024, DFF, HIDP}; LatentOrder S; S.init(1024, F.G, F.bid);
        pg8::EpiRes3<false, true> E{nullptr, nullptr, XR16, F.out, modv + 17 * 6144, 5, nullptr, nullptr, nullptr, modv, 0};
        pg8::gemm_phase<pg8::EpiRes3<false, true>, LatentOrder, true, true>(F.lds, g, S, E); }
#undef PH
#undef SEAM
#undef SSQP
}

#ifndef PROBE_ABL
#define PROBE_ABL 0
#endif
#ifndef N_LAUNCHES
#define N_LAUNCHES 1
#endif
extern "C" void kernel_launch(void* const* d_in, const int* in_sizes, int n_in, void* d_out, int out_size, void* d_ws, size_t ws_size, hipStream_t stream) {
    static int grid = 0;
    if (grid == 0) {
        if (n_in != 30 || out_size != NBATCH * SEQ * DM || ws_size < WS_END) { fprintf(stderr, "kernel_launch: unexpected problem: n_in %d out %d ws %zu (need %zu)\n", n_in, out_size, ws_size, (size_t)WS_END); grid = -1; return; }
        int dev = 0, cus = 0, per_cu = 0;
        if (hipGetDevice(&dev) != hipSuccess || hipDeviceGetAttribute(&cus, hipDeviceAttributeMultiprocessorCount, dev) != hipSuccess) { grid = -1; return; }
        if (hipFuncSetAttribute((const void*)fwd_kernel, hipFuncAttributeMaxDynamicSharedMemorySize, LDS_BYTES) != hipSuccess) { fprintf(stderr, "kernel_launch: hipFuncSetAttribute failed\n"); grid = -1; return; }
        if (hipOccupancyMaxActiveBlocksPerMultiprocessor(&per_cu, (const void*)fwd_kernel, 512, LDS_BYTES) != hipSuccess || per_cu < 1) { fprintf(stderr, "kernel_launch: occupancy query says %d\n", per_cu); (void)hipGetLastError(); per_cu = 1; }
        grid = cus * (per_cu > 1 ? 1 : per_cu);
        fprintf(stderr, "kernel_launch: cus %d per_cu %d grid %d ws %zu MiB\n", cus, per_cu, grid, ws_size >> 20);
        if (grid != 256) { fprintf(stderr, "kernel_launch: this build's static schedules need exactly 256 workgroups (one per CU of a 256-CU device); nothing launched\n"); grid = -1; return; }
    }
    if (grid < 0) return;
    unsigned char* ws = (unsigned char*)d_ws;
#if defined(PROBE_K) || N_LAUNCHES != 1
    (void)hipMemsetAsync(ws + WS_CTL, 0, CTL_ZERO_BYTES, stream);
#endif
    Params p{};
    for (int i = 0; i < 30; ++i) p.in[i] = (const float*)d_in[i];
    p.out = (float*)d_out; p.ws = ws;
#if defined(PROBE_K)
    for (int li = 0; li < 2; ++li) { p.ph_lo = li == 0 ? 0 : PROBE_K; p.ph_hi = li == 0 ? PROBE_K + PROBE_REP : N_PHASES; p.abl = li == 0 ? PROBE_ABL : 0;
        if (li == 1) (void)hipMemsetAsync(ws + WS_CTL, 0, CTL_ZERO_BYTES, stream);
        void* args[] = {&p};
        hipError_t e = hipLaunchCooperativeKernel((void*)fwd_kernel, dim3(grid), dim3(512), args, LDS_BYTES, stream);
        if (e != hipSuccess) fprintf(stderr, "cooperative launch failed: %s (grid %d)\n", hipGetErrorString(e), grid); }
#elif N_LAUNCHES == 1
    p.ph_lo = 0; p.ph_hi = N_PHASES;
    void* args[] = {&p};
    hipError_t e = hipLaunchCooperativeKernel((void*)fwd_kernel, dim3(grid), dim3(512), args, LDS_BYTES, stream);
    if (e != hipSuccess) fprintf(stderr, "cooperative launch failed: %s (grid %d)\n", hipGetErrorString(e), grid);
#else
    for (int k = 0; k < N_PHASES; ++k) { p.ph_lo = k; p.ph_hi = k + 1; hipLaunchKernelGGL(fwd_kernel, dim3(grid), dim3(512), LDS_BYTES, stream, p); }
#endif
}
```
